# Optimizing an MI355X kernel written in HIP

```python
import math
import jax, jax.numpy as jnp
from jax import lax
import numpy as np

D_MODEL = 1024
BATCH = 4
SEQ = 4096
DEPTH = 1

MIX_WIDTH = D_MODEL
RET_HEAD_DIM = 64
RET_WIDTH = MIX_WIDTH // 2
RET_HEADS = RET_WIDTH // RET_HEAD_DIM
RET_CHUNK = 128
DIFF_QK_DIM = 64
DIFF_V_DIM = 2 * DIFF_QK_DIM
DIFF_WIDTH = MIX_WIDTH - RET_WIDTH
DIFF_HEADS = DIFF_WIDTH // DIFF_V_DIM
DIFF_QK_WIDTH = DIFF_HEADS * 2 * DIFF_QK_DIM
IN_WIDTH = 4 * RET_WIDTH + 2 * DIFF_QK_WIDTH + DIFF_WIDTH
Q_BLOCK = 128
N_GROUPS = 4
EXPERTS_PER_GROUP = 8
TOP_K_INNER = 2
D_EXPERT = 512
N_MOD = 6
ROPE_BASE = 10000.0
EPS = 1e-6

kernel_name = 'hybrid_retention_diffattn_hmoe_adaln'


def rms_norm(x, gain):
    xf = x.astype(jnp.float32)
    y = xf * lax.rsqrt(jnp.mean(xf * xf, axis=-1, keepdims=True) + EPS)
    return (y * gain.astype(jnp.float32)).astype(x.dtype)


def modulate(h, shift, scale):
    return h * (1.0 + scale[:, None, :]) + shift[:, None, :]


def rotary(x, positions):
    half = x.shape[-1] // 2
    inv_freq = 1.0 / (ROPE_BASE ** (jnp.arange(half, dtype=jnp.float32) / half))
    ang = positions.astype(jnp.float32)[:, None] * inv_freq[None, :]
    cos = jnp.cos(ang)[None, :, None, :]
    sin = jnp.sin(ang)[None, :, None, :]
    x1, x2 = x[..., :half], x[..., half:]
    return jnp.concatenate([x1 * cos - x2 * sin, x2 * cos + x1 * sin], axis=-1)


def retention(q, k, v, g, gn_gain):
    out_dtype = v.dtype
    B, S, H, dh = q.shape
    C = RET_CHUNK
    nc = S // C
    f32 = jnp.float32
    pos = jnp.arange(S)
    q = rotary(q.astype(f32), pos)
    k = rotary(k.astype(f32), pos) * (dh ** -0.5)
    v = v.astype(f32)
    log_gamma = jnp.log(1.0 - jnp.exp2(-5.0 - jnp.arange(H, dtype=f32)))
    idx = jnp.arange(C)
    rel = (idx[:, None] - idx[None, :]).astype(f32)
    decay = jnp.where(rel[None] >= 0, jnp.exp(log_gamma[:, None, None] * jnp.maximum(rel, 0.0)[None]), 0.0)
    qc = q.reshape(B, nc, C, H, dh)
    kc = k.reshape(B, nc, C, H, dh)
    vc = v.reshape(B, nc, C, H, dh)
    scores = jnp.einsum('bnihd,bnjhd->bhnij', qc, kc) * decay[None, :, None]
    intra = jnp.einsum('bhnij,bnjhv->bnihv', scores, vc)
    k_dec = kc * jnp.exp(log_gamma[None, :] * (C - 1 - idx).astype(f32)[:, None])[:, :, None]
    states = jnp.einsum('bnjhk,bnjhv->nbhkv', k_dec, vc)
    chunk_decay = jnp.exp(log_gamma * C)[None, :, None, None]

    def step(R, s_n):
        return R * chunk_decay + s_n, R

    _, R_prev = lax.scan(step, jnp.zeros((B, H, dh, dh), f32), states)
    cross = jnp.einsum('bnihk,nbhkv->bnihv', qc, R_prev)
    cross = cross * jnp.exp(log_gamma[None, :] * (idx + 1).astype(f32)[:, None])[:, :, None]
    y = (intra + cross).reshape(B, S, H, dh)
    mu = jnp.mean(y, axis=-1, keepdims=True)
    var = jnp.mean(jnp.square(y - mu), axis=-1, keepdims=True)
    y = (y - mu) * lax.rsqrt(var + EPS) * gn_gain.astype(f32).reshape(H, dh)
    y = jax.nn.silu(g.astype(f32)) * y
    return y.reshape(B, S, H * dh).astype(out_dtype)


def diff_attention(q, k, v, lam_q1, lam_k1, lam_q2, lam_k2, subln_gain, lambda_init):
    B, S, H, _, dq = q.shape
    dv = v.shape[-1]
    nb = S // Q_BLOCK
    f32 = jnp.float32
    lam = (jnp.exp(jnp.sum(lam_q1.astype(f32) * lam_k1.astype(f32)))
           - jnp.exp(jnp.sum(lam_q2.astype(f32) * lam_k2.astype(f32))) + lambda_init)
    kt = k.transpose(0, 2, 3, 1, 4)
    vt = v.transpose(0, 2, 1, 3)
    qb = (q * (dq ** -0.5)).reshape(B, nb, Q_BLOCK, H, 2, dq).transpose(1, 0, 3, 4, 2, 5)
    key_pos = jnp.arange(S)
    neg = jnp.finfo(f32).min

    def block(args):
        q_blk, blk = args
        s = jnp.einsum('bhpqd,bhpkd->bhpqk', q_blk, kt).astype(f32)
        q_pos = blk * Q_BLOCK + jnp.arange(Q_BLOCK)
        mask = key_pos[None, :] <= q_pos[:, None]
        a = jax.nn.softmax(jnp.where(mask, s, neg), axis=-1)
        w = a[:, :, 0] - lam * a[:, :, 1]
        return jnp.einsum('bhqk,bhkv->bhqv', w.astype(vt.dtype), vt)

    o = lax.map(block, (qb, jnp.arange(nb)))
    o = o.transpose(1, 0, 3, 2, 4).reshape(B, S, H, dv)
    o = rms_norm(o, subln_gain) * (1.0 - lambda_init)
    return o.reshape(B, S, H * dv)


def hier_moe(h, w_group, b_group, w_expert, b_expert, w_gate, w_up, w_down):
    B, S, D = h.shape
    t = h.reshape(B * S, D)
    f32 = jnp.float32
    group_logits = (t @ w_group + b_group).astype(f32)
    group_prob = jax.nn.softmax(group_logits, axis=-1)
    g_idx = jnp.argmax(group_logits, axis=-1)
    g_weight = jnp.take_along_axis(group_prob, g_idx[:, None], axis=-1)
    expert_logits = (jnp.einsum('td,dge->tge', t, w_expert) + b_expert).astype(f32)
    sel_logits = jnp.take_along_axis(expert_logits, g_idx[:, None, None], axis=1)[:, 0]
    top_val, top_idx = lax.top_k(sel_logits, TOP_K_INNER)
    top_w = jax.nn.softmax(top_val, axis=-1) * g_weight
    inner = jnp.einsum('tk,tke->te', top_w, jax.nn.one_hot(top_idx, EXPERTS_PER_GROUP, dtype=f32))
    combine = (jax.nn.one_hot(g_idx, N_GROUPS, dtype=f32)[:, :, None] * inner[:, None, :]).astype(t.dtype)
    y = jnp.zeros_like(t)
    for grp in range(N_GROUPS):
        a = jnp.einsum('td,edf->tef', t, w_gate[grp])
        u = jnp.einsum('td,edf->tef', t, w_up[grp])
        hid = jax.nn.silu(a) * u * combine[:, grp, :, None]
        y = y + jnp.einsum('tef,efd->td', hid, w_down[grp])
    return y.reshape(B, S, D)


def setup_inputs(seed: int = 0) -> dict:
    key = jax.random.key(seed)
    ks = jax.random.split(key, 24)
    f32 = jnp.float32

    def nrm(k, shape, scale):
        return jax.random.normal(k, shape, f32) * scale

    def gain(k, shape):
        return 1.0 + 0.01 * jax.random.normal(k, shape, f32)

    L, D, G, E = DEPTH, D_MODEL, N_GROUPS, EXPERTS_PER_GROUP
    return {
        'x': nrm(ks[0], (BATCH, SEQ, D), 1.0),
        'c': nrm(ks[1], (BATCH, D), 1.0),
        'ada_w': nrm(ks[2], (L, D, N_MOD * D), 0.5 * D ** -0.5),
        'ada_b': nrm(ks[3], (L, N_MOD * D), 0.01),
        'norm1_gain': gain(ks[4], (L, D)),
        'norm2_gain': gain(ks[5], (L, D)),
        'w_in': nrm(ks[6], (L, D, IN_WIDTH), D ** -0.5),
        'w_out': nrm(ks[7], (L, MIX_WIDTH, D), MIX_WIDTH ** -0.5),
        'ret_gn_gain': gain(ks[8], (L, RET_WIDTH)),
        'lam_q1': nrm(ks[9], (L, DIFF_QK_DIM), 0.1),
        'lam_k1': nrm(ks[10], (L, DIFF_QK_DIM), 0.1),
        'lam_q2': nrm(ks[11], (L, DIFF_QK_DIM), 0.1),
        'lam_k2': nrm(ks[12], (L, DIFF_QK_DIM), 0.1),
        'diff_subln_gain': gain(ks[13], (L, DIFF_V_DIM)),
        'w_group': nrm(ks[14], (L, D, G), D ** -0.5),
        'b_group': nrm(ks[15], (L, G), 0.01),
        'w_expert': nrm(ks[16], (L, D, G, E), D ** -0.5),
        'b_expert': nrm(ks[17], (L, G, E), 0.01),
        'w_gate': nrm(ks[18], (L, G, E, D, D_EXPERT), D ** -0.5),
        'w_up': nrm(ks[19], (L, G, E, D, D_EXPERT), D ** -0.5),
        'w_down': nrm(ks[20], (L, G, E, D_EXPERT, D), D_EXPERT ** -0.5),
        'final_gain': gain(ks[21], (D,)),
    }


def reference(x, c, ada_w, ada_b, norm1_gain, norm2_gain, w_in, w_out, ret_gn_gain,
              lam_q1, lam_k1, lam_q2, lam_k2, diff_subln_gain, w_group, b_group,
              w_expert, b_expert, w_gate, w_up, w_down, final_gain):
    B, S, D = x.shape
    c_act = jax.nn.silu(c)
    splits = [RET_WIDTH, 2 * RET_WIDTH, 3 * RET_WIDTH, 4 * RET_WIDTH,
              4 * RET_WIDTH + DIFF_QK_WIDTH, 4 * RET_WIDTH + 2 * DIFF_QK_WIDTH]
    for layer in range(DEPTH):
        mod = (c_act @ ada_w[layer] + ada_b[layer]).reshape(B, N_MOD, D)
        shift1, scale1, gate1 = mod[:, 0], mod[:, 1], mod[:, 2]
        shift2, scale2, gate2 = mod[:, 3], mod[:, 4], mod[:, 5]
        lambda_init = 0.8 - 0.6 * math.exp(-0.3 * layer)

        h = modulate(rms_norm(x, norm1_gain[layer]), shift1, scale1)
        proj = h @ w_in[layer]
        rq, rk, rv, rg, dq_, dk_, dv_ = jnp.split(proj, splits, axis=-1)
        ret_shape = (B, S, RET_HEADS, RET_HEAD_DIM)
        ret_out = retention(rq.reshape(ret_shape), rk.reshape(ret_shape), rv.reshape(ret_shape),
                            rg.reshape(ret_shape), ret_gn_gain[layer])
        qk_shape = (B, S, DIFF_HEADS, 2, DIFF_QK_DIM)
        diff_out = diff_attention(dq_.reshape(qk_shape), dk_.reshape(qk_shape),
                                  dv_.reshape(B, S, DIFF_HEADS, DIFF_V_DIM),
                                  lam_q1[layer], lam_k1[layer], lam_q2[layer], lam_k2[layer],
                                  diff_subln_gain[layer], lambda_init)
        mix = jnp.concatenate([ret_out, diff_out], axis=-1)
        x = x + gate1[:, None, :] * (mix @ w_out[layer])

        h = modulate(rms_norm(x, norm2_gain[layer]), shift2, scale2)
        moe_out = hier_moe(h, w_group[layer], b_group[layer], w_expert[layer], b_expert[layer],
                           w_gate[layer], w_up[layer], w_down[layer])
        x = x + gate2[:, None, :] * moe_out
    return rms_norm(x, final_gain)
```

```cpp
#include <hip/hip_runtime.h>
#include <hip/hip_cooperative_groups.h>
#include <cstdio>
#include <cstdint>
#include <cmath>
namespace cg = cooperative_groups;

constexpr int D = 1024, NB = 4, SEQ = 4096, M = NB * SEQ;
constexpr int INW = 3584;
constexpr int OFF_RQ = 0, OFF_RK = 512, OFF_RV = 1024, OFF_RG = 1536, OFF_DQ = 2048, OFF_DK = 2560, OFF_DV = 3072;
constexpr int NEXP = 32, DE = 512, NMODW = 6 * D;
constexpr float EPS = 1e-6f;
constexpr float LAMBDA_INIT = 0.2f;
constexpr float LOG2E = 1.4426950408889634f;
constexpr float C2 = 0.125f * LOG2E;
constexpr int NT = 512;
constexpr int LISTCAP = 16384;

constexpr size_t MiB = 1u << 20;
constexpr size_t WS_MOD = 0;
constexpr size_t WS_ROPE_C = 128 * 1024;
constexpr size_t WS_ROPE_S = WS_ROPE_C + 512 * 1024;
constexpr size_t WS_CNT = WS_ROPE_S + 512 * 1024;
constexpr size_t WS_TOKSLOT = 2 * MiB;
constexpr size_t WS_LIST = 3 * MiB;
constexpr size_t WS_LISTW = 5 * MiB;
constexpr size_t WS_BIG = 8 * MiB;
constexpr size_t WS_PROJ = WS_BIG;
constexpr size_t WS_X1 = WS_BIG;
constexpr size_t WS_H2 = WS_X1 + 64 * MiB;
constexpr size_t WS_YACC = WS_H2 + 64 * MiB;
constexpr size_t WS_HID = WS_YACC + 64 * MiB;
constexpr size_t WS_END = WS_HID + 80 * MiB;
static_assert(WS_PROJ + (size_t)M * INW * 4 <= WS_END, "ws map");

struct Params {
    const float *x, *c, *ada_w, *ada_b, *g1, *g2, *w_in, *w_out, *ret_gn, *lq1, *lk1, *lq2, *lk2, *subln;
    const float *w_group, *b_group, *w_expert, *b_expert, *w_gate, *w_up, *w_down, *final_gain;
    float* out; unsigned char* ws;
    int ph_lo, ph_hi;
};

__device__ __forceinline__ float siluf(float v) { return v / (1.0f + __expf(-v)); }
__device__ __forceinline__ float wave_sum(float v) {
#pragma unroll
    for (int o = 1; o < 64; o <<= 1) v += __shfl_xor(v, o);
    return v;
}

template <bool DUAL, class Epi>
__device__ __forceinline__ void gemm_tile(const float* A, int lda, const int* rowidx, int nvalid, int m0,
                                          const float* B, const float* B2, int ldb, int n0, int K, float* sm, Epi epi) {
    constexpr int BM = 128, BN = 128, BK = 16, LDA_S = BM + 4;
    float* As = sm;
    float* Bs = sm + BK * LDA_S;
    float* Bs2 = Bs + BK * BN;
    const int tid = threadIdx.x;
    const int ar = tid >> 2, akq = (tid & 3) * 4;
    int arow;
    { int r = m0 + ar; if (r >= nvalid) r = nvalid - 1; arow = rowidx ? rowidx[r] : r; }
    const float* Ap = A + (size_t)arow * lda + akq;
    const int bk = tid >> 5, bn4 = (tid & 31) * 4;
    const float* Bp = B + (size_t)bk * ldb + n0 + bn4;
    const float* Bp2 = DUAL ? (B2 + (size_t)bk * ldb + n0 + bn4) : nullptr;
    const int ty = tid >> 5, tx = tid & 31;
    float acc[8][4], acc2[8][4];
#pragma unroll
    for (int i = 0; i < 8; ++i)
#pragma unroll
        for (int j = 0; j < 4; ++j) { acc[i][j] = 0.f; acc2[i][j] = 0.f; }
    for (int k0 = 0; k0 < K; k0 += BK) {
        const float4 av = *(const float4*)(Ap + k0);
        const float4 bv = *(const float4*)(Bp + (size_t)k0 * ldb);
        float4 bv2 = make_float4(0.f, 0.f, 0.f, 0.f);
        if (DUAL) bv2 = *(const float4*)(Bp2 + (size_t)k0 * ldb);
        __syncthreads();
        As[(akq + 0) * LDA_S + ar] = av.x; As[(akq + 1) * LDA_S + ar] = av.y; As[(akq + 2) * LDA_S + ar] = av.z; As[(akq + 3) * LDA_S + ar] = av.w;
        *(float4*)(Bs + bk * BN + bn4) = bv;
        if (DUAL) *(float4*)(Bs2 + bk * BN + bn4) = bv2;
        __syncthreads();
#pragma unroll 2
        for (int k = 0; k < BK; ++k) {
            const float4 a0 = *(const float4*)(As + k * LDA_S + ty * 8), a1 = *(const float4*)(As + k * LDA_S + ty * 8 + 4);
            const float4 b = *(const float4*)(Bs + k * BN + tx * 4);
            const float a[8] = {a0.x, a0.y, a0.z, a0.w, a1.x, a1.y, a1.z, a1.w};
            const float bb[4] = {b.x, b.y, b.z, b.w};
#pragma unroll
            for (int i = 0; i < 8; ++i)
#pragma unroll
                for (int j = 0; j < 4; ++j) acc[i][j] += a[i] * bb[j];
            if (DUAL) {
                const float4 b2 = *(const float4*)(Bs2 + k * BN + tx * 4);
                const float bb2[4] = {b2.x, b2.y, b2.z, b2.w};
#pragma unroll
                for (int i = 0; i < 8; ++i)
#pragma unroll
                    for (int j = 0; j < 4; ++j) acc2[i][j] += a[i] * bb2[j];
            }
        }
    }
#pragma unroll
    for (int i = 0; i < 8; ++i) {
        const int r = m0 + ty * 8 + i;
        if (r < nvalid) {
#pragma unroll
            for (int j = 0; j < 4; ++j) epi(r, n0 + tx * 4 + j, acc[i][j], acc2[i][j]);
        }
    }
    __syncthreads();
}

__device__ __forceinline__ unsigned ld_cnt(const unsigned* p) { return __hip_atomic_load(p, __ATOMIC_RELAXED, __HIP_MEMORY_SCOPE_AGENT); }

__device__ __forceinline__ void ph_n0(const Params& p, float* sm) {
    const int tid = threadIdx.x;
    float* mod = (float*)(p.ws + WS_MOD);
    float* csil = sm;
    float* red = sm + 4096;
    for (int i = tid; i < 4096; i += NT) csil[i] = siluf(p.c[i]);
    __syncthreads();
    const int col = tid & 31, ks = tid >> 5;
    for (int it = blockIdx.x; it < NMODW / 32; it += gridDim.x) {
        const int n0 = it * 32;
        float a0 = 0.f, a1 = 0.f, a2 = 0.f, a3 = 0.f;
        for (int k = ks * 64; k < ks * 64 + 64; ++k) {
            const float w = p.ada_w[(size_t)k * NMODW + n0 + col];
            a0 += csil[k] * w; a1 += csil[1024 + k] * w; a2 += csil[2048 + k] * w; a3 += csil[3072 + k] * w;
        }
        red[(ks * 4 + 0) * 32 + col] = a0; red[(ks * 4 + 1) * 32 + col] = a1; red[(ks * 4 + 2) * 32 + col] = a2; red[(ks * 4 + 3) * 32 + col] = a3;
        __syncthreads();
        if (tid < 128) {
            const int b = tid >> 5, cc = tid & 31;
            float s = p.ada_b[n0 + cc];
            for (int q = 0; q < 16; ++q) s += red[(q * 4 + b) * 32 + cc];
            mod[b * NMODW + n0 + cc] = s;
        }
        __syncthreads();
    }
    float* rc = (float*)(p.ws + WS_ROPE_C); float* rs = (float*)(p.ws + WS_ROPE_S);
    for (int i = blockIdx.x * NT + tid; i < SEQ * 32; i += gridDim.x * NT) {
        const int pos = i >> 5, d = i & 31;
        const float inv = 1.0f / powf(10000.0f, (float)d / 32.0f);
        const float ang = (float)pos * inv;
        const double tq = (double)ang * 0.15915494309189535;
        const float fr = (float)(tq - rint(tq));
        rc[i] = __builtin_amdgcn_cosf(fr); rs[i] = __builtin_amdgcn_sinf(fr);
    }
    if (blockIdx.x == 0 && tid < 64) ((unsigned*)(p.ws + WS_CNT))[tid] = 0u;
}

__device__ __forceinline__ void ph_n1(const Params& p, float* h1) {
    const float* mod = (const float*)(p.ws + WS_MOD);
    const int lane = threadIdx.x & 63, wave = threadIdx.x >> 6;
    for (int row = blockIdx.x * 8 + wave; row < M; row += gridDim.x * 8) {
        const int b = row >> 12;
        const float4* xr = (const float4*)(p.x + (size_t)row * D);
        float4 v[4]; float ss = 0.f;
#pragma unroll
        for (int j = 0; j < 4; ++j) { v[j] = xr[lane + 64 * j]; ss += v[j].x * v[j].x + v[j].y * v[j].y + v[j].z * v[j].z + v[j].w * v[j].w; }
        ss = wave_sum(ss);
        const float rstd = 1.0f / sqrtf(ss * (1.0f / D) + EPS);
#pragma unroll
        for (int j = 0; j < 4; ++j) {
            const int c0 = 4 * (lane + 64 * j);
            const float4 g = *(const float4*)(p.g1 + c0);
            const float4 sh = *(const float4*)(mod + b * NMODW + 0 * D + c0);
            const float4 sc = *(const float4*)(mod + b * NMODW + 1 * D + c0);
            float4 o;
            o.x = v[j].x * rstd * g.x * (1.0f + sc.x) + sh.x; o.y = v[j].y * rstd * g.y * (1.0f + sc.y) + sh.y;
            o.z = v[j].z * rstd * g.z * (1.0f + sc.z) + sh.z; o.w = v[j].w * rstd * g.w * (1.0f + sc.w) + sh.w;
            *(float4*)(h1 + (size_t)row * D + c0) = o;
        }
    }
}

__device__ __forceinline__ void ph_n2(const Params& p, const float* h1, float* sm) {
    float* proj = (float*)(p.ws + WS_PROJ);
    const int nMt = M / 128, nNt = INW / 128;
    for (int it = blockIdx.x; it < nMt * nNt; it += gridDim.x) {
        const int mt = it / nNt, nt = it % nNt;
        gemm_tile<false>(h1, D, nullptr, M, mt * 128, p.w_in, nullptr, INW, nt * 128, D, sm,
                         [=](int r, int cidx, float v, float) { proj[(size_t)r * INW + cidx] = v; });
    }
}

__device__ __forceinline__ void ph_n3(const Params& p) {
    float* proj = (float*)(p.ws + WS_PROJ);
    const float* rc = (const float*)(p.ws + WS_ROPE_C); const float* rs = (const float*)(p.ws + WS_ROPE_S);
    const size_t gt = (size_t)blockIdx.x * NT + threadIdx.x, gs = (size_t)gridDim.x * NT;
    for (size_t i = gt; i < (size_t)M * 512; i += gs) {
        const int d = (int)(i & 31), h = (int)((i >> 5) & 7), which = (int)((i >> 8) & 1); const size_t t = i >> 9;
        const int pos = (int)(t & (SEQ - 1));
        float* q = proj + t * INW + (which ? OFF_RK : OFF_RQ) + h * 64 + d;
        const float c = rc[pos * 32 + d], s = rs[pos * 32 + d];
        const float x1 = q[0], x2 = q[32];
        float o1 = x1 * c - x2 * s, o2 = x2 * c + x1 * s;
        if (which) { o1 *= 0.125f; o2 *= 0.125f; }
        q[0] = o1; q[32] = o2;
    }
    for (size_t i = gt; i < (size_t)M * 512; i += gs) {
        const size_t t = i >> 9; const int cidx = (int)(i & 511);
        proj[t * INW + OFF_DQ + cidx] *= C2;
    }
}

__device__ __forceinline__ void ph_n4(const Params& p, float* mix, float* sm) {
    const float* proj = (const float*)(p.ws + WS_PROJ);
    float* Qs = sm;
    float* Ks = Qs + 16 * 64;
    float* Vs = Ks + 64 * 65;
    float* Ss = Vs + 64 * 64;
    const int tid = threadIdx.x;
    for (int it = blockIdx.x; it < NB * 8 * 256; it += gridDim.x) {
        const int rg = it & 255, h = (it >> 8) & 7, b = it >> 11;
        const int i0 = rg * 16;
        const float lg = logf(1.0f - exp2f(-5.0f - (float)h));
        const size_t tb = (size_t)b * SEQ;
        __syncthreads();
        for (int e = tid; e < 16 * 64; e += NT) { const int r = e >> 6, d = e & 63; Qs[e] = proj[(tb + i0 + r) * INW + OFF_RQ + h * 64 + d]; }
        const int r = tid >> 5, dd = tid & 31;
        float acc0 = 0.f, acc1 = 0.f;
        const int ntile = (i0 + 15) / 64 + 1;
        for (int jt = 0; jt < ntile; ++jt) {
            const int j0 = jt * 64;
            __syncthreads();
            for (int e = tid; e < 64 * 64; e += NT) { const int j = e >> 6, d = e & 63;
                Ks[j * 65 + d] = proj[(tb + j0 + j) * INW + OFF_RK + h * 64 + d];
                Vs[j * 64 + d] = proj[(tb + j0 + j) * INW + OFF_RV + h * 64 + d]; }
            __syncthreads();
#pragma unroll
            for (int cix = 0; cix < 2; ++cix) {
                const int jj = dd + 32 * cix; float s = 0.f;
                for (int d = 0; d < 64; ++d) s += Qs[r * 64 + d] * Ks[jj * 65 + d];
                const int i = i0 + r, j = j0 + jj;
                const float w = (j <= i) ? __expf(lg * (float)(i - j)) : 0.f;
                Ss[r * 64 + jj] = s * w;
            }
            __syncthreads();
            for (int j = 0; j < 64; ++j) { const float s = Ss[r * 64 + j]; acc0 += s * Vs[j * 64 + dd]; acc1 += s * Vs[j * 64 + dd + 32]; }
        }
        float s1 = acc0 + acc1;
#pragma unroll
        for (int o = 1; o < 32; o <<= 1) s1 += __shfl_xor(s1, o);
        const float mu = s1 * (1.0f / 64.0f);
        const float d0 = acc0 - mu, d1 = acc1 - mu;
        float s2 = d0 * d0 + d1 * d1;
#pragma unroll
        for (int o = 1; o < 32; o <<= 1) s2 += __shfl_xor(s2, o);
        const float rstd = 1.0f / sqrtf(s2 * (1.0f / 64.0f) + EPS);
        const size_t t = tb + i0 + r;
        const float gA = proj[t * INW + OFF_RG + h * 64 + dd], gB = proj[t * INW + OFF_RG + h * 64 + dd + 32];
        mix[t * D + h * 64 + dd] = d0 * rstd * p.ret_gn[h * 64 + dd] * siluf(gA);
        mix[t * D + h * 64 + dd + 32] = d1 * rstd * p.ret_gn[h * 64 + dd + 32] * siluf(gB);
    }
}

__device__ __forceinline__ void ph_n5(const Params& p, float* mix, float* sm) {
    const float* proj = (const float*)(p.ws + WS_PROJ);
    float* Q0 = sm;
    float* Q1 = Q0 + 1024;
    float* K0 = Q1 + 1024;
    float* K1 = K0 + 64 * 65;
    float* Vs = K1 + 64 * 65;
    float* S0 = Vs + 64 * 128;
    float* S1 = S0 + 1024;
    const int tid = threadIdx.x;
    float lam;
    { float a = 0.f, bq = 0.f; for (int i = 0; i < 64; ++i) { a += p.lq1[i] * p.lk1[i]; bq += p.lq2[i] * p.lk2[i]; } lam = expf(a) - expf(bq) + LAMBDA_INIT; }
    for (int it = blockIdx.x; it < NB * 4 * 256; it += gridDim.x) {
        const int rg = it & 255, h = (it >> 8) & 3, b = it >> 10;
        const int i0 = rg * 16; const size_t tb = (size_t)b * SEQ;
        __syncthreads();
        for (int e = tid; e < 1024; e += NT) { const int r = e >> 6, d = e & 63;
            Q0[e] = proj[(tb + i0 + r) * INW + OFF_DQ + h * 128 + d];
            Q1[e] = proj[(tb + i0 + r) * INW + OFF_DQ + h * 128 + 64 + d]; }
        const int map = tid >> 8, sr = (tid >> 4) & 15, jq = tid & 15;
        const float* Qm = map ? Q1 : Q0; const float* Km = map ? K1 : K0; float* Sm = map ? S1 : S0;
        const int ntile = (i0 + 15) / 64 + 1;
        float mrun = -INFINITY, lrun = 0.f;
        for (int pass = 0; pass < 2; ++pass) {
            const int orow = tid >> 5, odd = tid & 31;
            float oacc[4] = {0.f, 0.f, 0.f, 0.f};
            const float rl = (pass == 1) ? 1.0f / lrun : 0.f;
            for (int jt = 0; jt < ntile; ++jt) {
                const int j0 = jt * 64;
                __syncthreads();
                for (int e = tid; e < 4096; e += NT) { const int j = e >> 6, d = e & 63;
                    K0[j * 65 + d] = proj[(tb + j0 + j) * INW + OFF_DK + h * 128 + d];
                    K1[j * 65 + d] = proj[(tb + j0 + j) * INW + OFF_DK + h * 128 + 64 + d]; }
                if (pass == 1) for (int e = tid; e < 8192; e += NT) { const int j = e >> 7, d = e & 127; Vs[e] = proj[(tb + j0 + j) * INW + OFF_DV + h * 128 + d]; }
                __syncthreads();
                float s[4];
#pragma unroll
                for (int cix = 0; cix < 4; ++cix) {
                    const int jj = jq + 16 * cix; float a = 0.f;
                    for (int d = 0; d < 64; ++d) a += Qm[sr * 64 + d] * Km[jj * 65 + d];
                    s[cix] = (j0 + jj <= i0 + sr) ? a : -INFINITY;
                }
                if (pass == 0) {
                    float tm = fmaxf(fmaxf(s[0], s[1]), fmaxf(s[2], s[3]));
#pragma unroll
                    for (int o = 1; o < 16; o <<= 1) tm = fmaxf(tm, __shfl_xor(tm, o));
                    const float mn = fmaxf(mrun, tm);
                    float ps = exp2f(s[0] - mn) + exp2f(s[1] - mn) + exp2f(s[2] - mn) + exp2f(s[3] - mn);
#pragma unroll
                    for (int o = 1; o < 16; o <<= 1) ps += __shfl_xor(ps, o);
                    lrun = lrun * exp2f(mrun - mn) + ps; mrun = mn;
                } else {
#pragma unroll
                    for (int cix = 0; cix < 4; ++cix) Sm[sr * 64 + jq + 16 * cix] = exp2f(s[cix] - mrun) * rl;
                    __syncthreads();
                    for (int j = 0; j < 64; ++j) {
                        const float w = S0[orow * 64 + j] - lam * S1[orow * 64 + j];
#pragma unroll
                        for (int cix = 0; cix < 4; ++cix) oacc[cix] += w * Vs[j * 128 + odd + 32 * cix];
                    }
                }
            }
            if (pass == 1) {
                float ss = oacc[0] * oacc[0] + oacc[1] * oacc[1] + oacc[2] * oacc[2] + oacc[3] * oacc[3];
#pragma unroll
                for (int o = 1; o < 32; o <<= 1) ss += __shfl_xor(ss, o);
                const float rstd = 1.0f / sqrtf(ss * (1.0f / 128.0f) + EPS);
                const size_t t = tb + i0 + orow;
#pragma unroll
                for (int cix = 0; cix < 4; ++cix) { const int d = odd + 32 * cix; mix[t * D + 512 + h * 128 + d] = oacc[cix] * rstd * p.subln[d] * (1.0f - LAMBDA_INIT); }
            }
        }
    }
}

__device__ __forceinline__ void ph_n6(const Params& p, const float* mix, float* sm) {
    float* x1 = (float*)(p.ws + WS_X1); const float* mod = (const float*)(p.ws + WS_MOD); const float* x = p.x;
    for (int it = blockIdx.x; it < (M / 128) * (D / 128); it += gridDim.x) {
        const int mt = it / (D / 128), nt = it % (D / 128);
        gemm_tile<false>(mix, D, nullptr, M, mt * 128, p.w_out, nullptr, D, nt * 128, D, sm,
                         [=](int r, int cidx, float v, float) { const int b = r >> 12; x1[(size_t)r * D + cidx] = x[(size_t)r * D + cidx] + mod[b * NMODW + 2 * D + cidx] * v; });
    }
}

__device__ __forceinline__ void ph_n7(const Params& p) {
    const float* x1 = (const float*)(p.ws + WS_X1); float* h2 = (float*)(p.ws + WS_H2); float* yacc = (float*)(p.ws + WS_YACC);
    const float* mod = (const float*)(p.ws + WS_MOD);
    unsigned* cnt = (unsigned*)(p.ws + WS_CNT); unsigned* tokslot = (unsigned*)(p.ws + WS_TOKSLOT);
    int* list = (int*)(p.ws + WS_LIST); float* listw = (float*)(p.ws + WS_LISTW);
    const int lane = threadIdx.x & 63, wave = threadIdx.x >> 6;
    for (int row = blockIdx.x * 8 + wave; row < M; row += gridDim.x * 8) {
        const int b = row >> 12;
        const float4* xr = (const float4*)(x1 + (size_t)row * D);
        float4 v[4]; float ss = 0.f;
#pragma unroll
        for (int j = 0; j < 4; ++j) { v[j] = xr[lane + 64 * j]; ss += v[j].x * v[j].x + v[j].y * v[j].y + v[j].z * v[j].z + v[j].w * v[j].w; }
        ss = wave_sum(ss);
        const float rstd = 1.0f / sqrtf(ss * (1.0f / D) + EPS);
        float lg[36];
#pragma unroll
        for (int q = 0; q < 36; ++q) lg[q] = 0.f;
#pragma unroll
        for (int j = 0; j < 4; ++j) {
            const int c0 = 4 * (lane + 64 * j);
            const float4 g = *(const float4*)(p.g2 + c0);
            const float4 sh = *(const float4*)(mod + b * NMODW + 3 * D + c0);
            const float4 sc = *(const float4*)(mod + b * NMODW + 4 * D + c0);
            float4 hv;
            hv.x = v[j].x * rstd * g.x * (1.0f + sc.x) + sh.x; hv.y = v[j].y * rstd * g.y * (1.0f + sc.y) + sh.y;
            hv.z = v[j].z * rstd * g.z * (1.0f + sc.z) + sh.z; hv.w = v[j].w * rstd * g.w * (1.0f + sc.w) + sh.w;
            *(float4*)(h2 + (size_t)row * D + c0) = hv;
            *(float4*)(yacc + (size_t)row * D + c0) = make_float4(0.f, 0.f, 0.f, 0.f);
        }
#pragma unroll 1
        for (int kk = 0; kk < 16; ++kk) {
            const int k = 4 * (lane + 64 * (kk >> 2)) + (kk & 3);
            const float hvk = h2[(size_t)row * D + k];
            const float4 wg = *(const float4*)(p.w_group + (size_t)k * 4);
            lg[0] += hvk * wg.x; lg[1] += hvk * wg.y; lg[2] += hvk * wg.z; lg[3] += hvk * wg.w;
#pragma unroll
            for (int q = 0; q < 8; ++q) {
                const float4 we = *(const float4*)(p.w_expert + (size_t)k * 32 + q * 4);
                lg[4 + q * 4 + 0] += hvk * we.x; lg[4 + q * 4 + 1] += hvk * we.y; lg[4 + q * 4 + 2] += hvk * we.z; lg[4 + q * 4 + 3] += hvk * we.w;
            }
        }
#pragma unroll
        for (int q = 0; q < 36; ++q) lg[q] = wave_sum(lg[q]);
        if (lane == 0) {
            float gl[4]; int gi = 0;
#pragma unroll
            for (int q = 0; q < 4; ++q) gl[q] = lg[q] + p.b_group[q];
            float gmax = gl[0];
#pragma unroll
            for (int q = 1; q < 4; ++q) if (gl[q] > gmax) { gmax = gl[q]; gi = q; }
            float den = 0.f;
#pragma unroll
            for (int q = 0; q < 4; ++q) den += expf(gl[q] - gmax);
            const float gw = 1.0f / den;
            float el[8];
#pragma unroll
            for (int q = 0; q < 8; ++q) {
                float vsel = lg[4 + q];
                if (gi == 1) vsel = lg[4 + 8 + q]; else if (gi == 2) vsel = lg[4 + 16 + q]; else if (gi == 3) vsel = lg[4 + 24 + q];
                el[q] = vsel + p.b_expert[gi * 8 + q];
            }
            int i1 = 0; float v1 = el[0];
#pragma unroll
            for (int q = 1; q < 8; ++q) if (el[q] > v1) { v1 = el[q]; i1 = q; }
            int i2 = -1; float v2 = -INFINITY;
#pragma unroll
            for (int q = 0; q < 8; ++q) if (q != i1 && el[q] > v2) { v2 = el[q]; i2 = q; }
            const float e2 = expf(v2 - v1);
            const float w1 = gw / (1.0f + e2), w2 = gw * e2 / (1.0f + e2);
            const int ea = gi * 8 + i1, eb = gi * 8 + i2;
            const unsigned pa = atomicAdd(&cnt[ea], 1u), pb = atomicAdd(&cnt[eb], 1u);
            list[ea * LISTCAP + pa] = row; listw[ea * LISTCAP + pa] = w1;
            list[eb * LISTCAP + pb] = row; listw[eb * LISTCAP + pb] = w2;
            tokslot[row * 2 + 0] = ((unsigned)ea << 16) | pa; tokslot[row * 2 + 1] = ((unsigned)eb << 16) | pb;
        }
    }
}

__device__ __forceinline__ void ph_n8(const Params& p, float* sm) {
    const float* h2 = (const float*)(p.ws + WS_H2); float* hid = (float*)(p.ws + WS_HID);
    const unsigned* cnt = (const unsigned*)(p.ws + WS_CNT);
    const int* list = (const int*)(p.ws + WS_LIST); const float* listw = (const float*)(p.ws + WS_LISTW);
    int it = blockIdx.x, base = 0, offs = 0;
    for (int e = 0; e < NEXP; ++e) {
        const int ce = (int)ld_cnt(cnt + e); const int nit = ((ce + 127) / 128) * 4;
        while (it < base + nit) {
            const int li = it - base, mt = li >> 2, nt = li & 3;
            float* hrow = hid + (size_t)offs * DE; const float* lw = listw + e * LISTCAP;
            gemm_tile<true>(h2, D, list + e * LISTCAP, ce, mt * 128, p.w_gate + (size_t)e * D * DE, p.w_up + (size_t)e * D * DE, DE, nt * 128, D, sm,
                            [=](int r, int cidx, float a, float u) { hrow[(size_t)r * DE + cidx] = siluf(a) * u * lw[r]; });
            it += gridDim.x;
        }
        base += nit; offs += ((ce + 255) / 256) * 256;
    }
}

__device__ __forceinline__ void ph_n9(const Params& p, float* sm) {
    const float* hid = (const float*)(p.ws + WS_HID); float* yacc = (float*)(p.ws + WS_YACC);
    const unsigned* cnt = (const unsigned*)(p.ws + WS_CNT); const int* list = (const int*)(p.ws + WS_LIST);
    int it = blockIdx.x, base = 0, offs = 0;
    for (int e = 0; e < NEXP; ++e) {
        const int ce = (int)ld_cnt(cnt + e); const int nit = ((ce + 127) / 128) * 8;
        while (it < base + nit) {
            const int li = it - base, mt = li >> 3, nt = li & 7;
            const int* le = list + e * LISTCAP;
            gemm_tile<false>(hid + (size_t)offs * DE, DE, nullptr, ce, mt * 128, p.w_down + (size_t)e * DE * D, nullptr, D, nt * 128, DE, sm,
                             [=](int r, int cidx, float v, float) { atomicAdd(&yacc[(size_t)le[r] * D + cidx], v); });
            it += gridDim.x;
        }
        base += nit; offs += ((ce + 255) / 256) * 256;
    }
}

__device__ __forceinline__ void ph_n10(const Params& p) {
    const float* x1 = (const float*)(p.ws + WS_X1); const float* yacc = (const float*)(p.ws + WS_YACC); const float* mod = (const float*)(p.ws + WS_MOD);
    const int lane = threadIdx.x & 63, wave = threadIdx.x >> 6;
    for (int row = blockIdx.x * 8 + wave; row < M; row += gridDim.x * 8) {
        const int b = row >> 12;
        float4 v[4]; float ss = 0.f;
#pragma unroll
        for (int j = 0; j < 4; ++j) {
            const int c0 = 4 * (lane + 64 * j);
            const float4 a = *(const float4*)(x1 + (size_t)row * D + c0), y = *(const float4*)(yacc + (size_t)row * D + c0), g = *(const float4*)(mod + b * NMODW + 5 * D + c0);
            v[j].x = a.x + g.x * y.x; v[j].y = a.y + g.y * y.y; v[j].z = a.z + g.z * y.z; v[j].w = a.w + g.w * y.w;
            ss += v[j].x * v[j].x + v[j].y * v[j].y + v[j].z * v[j].z + v[j].w * v[j].w;
        }
        ss = wave_sum(ss);
        const float rstd = 1.0f / sqrtf(ss * (1.0f / D) + EPS);
#pragma unroll
        for (int j = 0; j < 4; ++j) {
            const int c0 = 4 * (lane + 64 * j);
            const float4 g = *(const float4*)(p.final_gain + c0);
            *(float4*)(p.out + (size_t)row * D + c0) = make_float4(v[j].x * rstd * g.x, v[j].y * rstd * g.y, v[j].z * rstd * g.z, v[j].w * rstd * g.w);
        }
    }
}

constexpr int LDS_BYTES = 96 * 1024;
constexpr int NPHASE = 10;

__global__ void __launch_bounds__(NT) mega(Params p) {
    extern __shared__ __attribute__((aligned(16))) unsigned char lds_raw[];
    float* sm = (float*)lds_raw;
    cg::grid_group grid = cg::this_grid();
    float* scratch_out = p.out;
#define PH(k) (p.ph_lo <= (k) && (k) < p.ph_hi)
#define SYNC(k) do { if (PH(k) && PH((k) + 1)) grid.sync(); } while (0)
    if (PH(0)) ph_n0(p, sm);
    SYNC(0);
    if (PH(1)) ph_n1(p, scratch_out);
    SYNC(1);
    if (PH(2)) ph_n2(p, scratch_out, sm);
    SYNC(2);
    if (PH(3)) ph_n3(p);
    SYNC(3);
    if (PH(4)) { ph_n4(p, scratch_out, sm); ph_n5(p, scratch_out, sm); }
    SYNC(4);
    if (PH(5)) ph_n6(p, scratch_out, sm);
    SYNC(5);
    if (PH(6)) ph_n7(p);
    SYNC(6);
    if (PH(7)) ph_n8(p, sm);
    SYNC(7);
    if (PH(8)) ph_n9(p, sm);
    SYNC(8);
    if (PH(9)) ph_n10(p);
#undef PH
#undef SYNC
}

#ifndef N_LAUNCHES
#define N_LAUNCHES 1
#endif

extern "C" void kernel_launch(void* const* d_in, const int* in_sizes, int n_in, void* d_out, int out_size, void* d_ws, size_t ws_size, hipStream_t stream) {
    static int grid = 0;
    if (grid == 0) {
        if (n_in != 22 || in_sizes[0] != M * D || out_size != M * D || ws_size < WS_END) {
            fprintf(stderr, "kernel_launch: unexpected shapes (n_in %d, in0 %d, out %d, ws %zu)\n", n_in, n_in > 0 ? in_sizes[0] : -1, out_size, ws_size); grid = -1; return; }
        int dev = 0, cus = 0, per_cu = 0;
        hipGetDevice(&dev);
        hipDeviceGetAttribute(&cus, hipDeviceAttributeMultiprocessorCount, dev);
        hipFuncSetAttribute((const void*)mega, hipFuncAttributeMaxDynamicSharedMemorySize, LDS_BYTES);
        hipOccupancyMaxActiveBlocksPerMultiprocessor(&per_cu, (const void*)mega, NT, LDS_BYTES);
        if (per_cu < 1) { fprintf(stderr, "kernel_launch: occupancy query says %d\n", per_cu); grid = -1; return; }
        grid = cus;
    }
    if (grid < 0) return;
    Params p{};
    const float** f = (const float**)&p;
    for (int i = 0; i < 22; ++i) f[i] = (const float*)d_in[i];
    p.out = (float*)d_out; p.ws = (unsigned char*)d_ws;
    if (N_LAUNCHES == 1) {
        p.ph_lo = 0; p.ph_hi = NPHASE;
        void* args[] = {&p};
        hipError_t e = hipLaunchCooperativeKernel((void*)mega, dim3(grid), dim3(NT), args, LDS_BYTES, stream);
        if (e != hipSuccess) fprintf(stderr, "cooperative launch failed: %s (grid %d)\n", hipGetErrorString(e), grid);
    } else {
        for (int k = 0; k < NPHASE; ++k) { p.ph_lo = k; p.ph_hi = k + 1; hipLaunchKernelGGL(mega, dim3(grid), dim3(NT), LDS_BYTES, stream, p); }
    }
}
```

```cpp
#include <hip/hip_runtime.h>
#include <hip/hip_cooperative_groups.h>
#include <cstdio>
#include <cstdint>
#include <cmath>
namespace cg = cooperative_groups;

constexpr int D = 1024, NB = 4, SEQ = 4096, M = NB * SEQ;
constexpr int INW = 3584;
constexpr int OFF_RQ = 0, OFF_RK = 512, OFF_RV = 1024, OFF_RG = 1536, OFF_DQ = 2048, OFF_DK = 2560, OFF_DV = 3072;
constexpr int NEXP = 32, DE = 512, NMODW = 6 * D;
constexpr float EPS = 1e-6f;
constexpr float LAMBDA_INIT = 0.2f;
constexpr float LOG2E = 1.4426950408889634f;
constexpr float C2 = 0.125f * LOG2E;
constexpr int NT = 512;
constexpr int LISTCAP = 16384;
constexpr int RCH = 128;

#define LAS __attribute__((address_space(3)))
typedef unsigned short bf16_t;
typedef short bf16x8 __attribute__((ext_vector_type(8)));
typedef float f32x4 __attribute__((ext_vector_type(4)));
typedef float f32x16 __attribute__((ext_vector_type(16)));
typedef unsigned u32x4 __attribute__((ext_vector_type(4)));
typedef unsigned u32x2 __attribute__((ext_vector_type(2)));

__device__ __forceinline__ float siluf(float v) { return v / (1.0f + __expf(-v)); }
__device__ __forceinline__ float wave_sum(float v) {
#pragma unroll
    for (int o = 1; o < 64; o <<= 1) v += __shfl_xor(v, o);
    return v;
}
__device__ __forceinline__ unsigned f2bf(float f) { unsigned u = __builtin_bit_cast(unsigned, f); return (u + 0x7fffu + ((u >> 16) & 1u)) >> 16; }
__device__ __forceinline__ unsigned pk2(float lo, float hi) { return f2bf(lo) | (f2bf(hi) << 16); }
__device__ __forceinline__ float bf2f(bf16_t v) { return __builtin_bit_cast(float, (unsigned)v << 16); }
__device__ __forceinline__ float bflo(unsigned w) { return __builtin_bit_cast(float, w << 16); }
__device__ __forceinline__ float bfhi(unsigned w) { return __builtin_bit_cast(float, w & 0xffff0000u); }
__device__ __forceinline__ unsigned ld_cnt(const unsigned* p) { return __hip_atomic_load(p, __ATOMIC_RELAXED, __HIP_MEMORY_SCOPE_AGENT); }
namespace pg8 {
constexpr int BM = 256, BK = 64, HALF = 128, HTB = HALF * BK * 2  , STAGE_BYTES = 8 * HTB;

__host__ __device__ __forceinline__ int lds_byte(int r, int c) { const int st = (r >> 4) * 2 + (c >> 5), rr = r & 15, cc = c & 31, ob = rr * 64 + cc * 2; return st * 1024 + (ob ^ (((ob >> 9) & 1) << 5)); }
__host__ __device__ __forceinline__ void stage_rc(int b, int& R, int& C) { const int st = b / 1024, sb = b % 1024, swz = sb ^ (((sb >> 9) & 1) << 5); R = (st >> 1) * 16 + swz / 64; C = (st & 1) * 32 + (swz % 64) / 2; }
__host__ __device__ __forceinline__ int perm32(int rho) { const int n = rho >> 4, i = rho & 15; return 8 * (i >> 2) + 4 * n + (i & 3); }

struct Unit { const char* a; const char* b; const int* rows; int nvalid; int pm, pn, aux; };

__device__ __forceinline__ unsigned cvt_pk_bf16(float lo, float hi) { typedef float f32x2_t __attribute__((ext_vector_type(2))); typedef __bf16 bf16x2_t __attribute__((ext_vector_type(2))); f32x2_t v = {lo, hi}; bf16x2_t b = __builtin_convertvector(v, bf16x2_t); return __builtin_bit_cast(unsigned, b); }

template <class Epi, class Sched, bool ALIGN_EPI, bool GATHER>
__device__ __forceinline__ void gemm_phase(LAS unsigned char* lds, const int K, const Sched& S, const Epi& E) {
    const int tid = threadIdx.x, wid = __builtin_amdgcn_readfirstlane(tid >> 6), lane = tid & 63, wr = wid >> 2, wc = wid & 3, fr = lane & 15, fq = lane >> 4;
    const int nt = K / BK;
    int Rr[2], Cc[2]; unsigned voffB[2];
#pragma unroll
    for (int i = 0; i < 2; ++i) { int R, C; stage_rc(tid * 16 + i * 8192, R, C); const int Rb = Epi::PERM ? ((R & ~31) + perm32(R & 31)) : R;
        Rr[i] = R; Cc[i] = C; voffB[i] = (unsigned)(Rb * K + C) * 2u; }
    const size_t kstep = (size_t)(BK * 2);
    const size_t hstep = (size_t)HALF * K * 2;
    const unsigned ldsw = (unsigned)wid * 1024u;
    const int aoff = lds_byte(wr * 64 + fr, fq * 8), boff = lds_byte(wc * 32 + fr, fq * 8);
#define PG8_SA(b, h) (((b) * 2 + (h)) * HTB)
#define PG8_SB(b, h) ((4 + (b) * 2 + (h)) * HTB)
#define PG8_STAGE(bufoff, gbase, voff) do { _Pragma("unroll") for (int _i = 0; _i < 2; ++_i) \
        __builtin_amdgcn_global_load_lds((const unsigned*)((const char*)(gbase) + (voff)[_i]), (LAS unsigned*)(lds + (bufoff) + ldsw + _i * 8192), 16, 0, 0); } while (0)
#define PG8_LDA(dst, b, h) do { _Pragma("unroll") for (int m = 0; m < 4; ++m) _Pragma("unroll") for (int k = 0; k < 2; ++k) dst[m][k] = *(const LAS bf16x8*)(lds + PG8_SA(b, h) + aoff + m * 2048 + k * 1024); } while (0)
#define PG8_LDB(dst, b, h) do { _Pragma("unroll") for (int n = 0; n < 2; ++n) _Pragma("unroll") for (int k = 0; k < 2; ++k) dst[n][k] = *(const LAS bf16x8*)(lds + PG8_SB(b, h) + boff + n * 2048 + k * 1024); } while (0)
#define PG8_MMA(ai, bj, At, Bt) do { __builtin_amdgcn_s_setprio(1); _Pragma("unroll") for (int m = 0; m < 4; ++m) _Pragma("unroll") for (int n = 0; n < 2; ++n) _Pragma("unroll") for (int k = 0; k < 2; ++k) \
        acc[ai][bj][m][n] = __builtin_amdgcn_mfma_f32_16x16x32_bf16(Bt[n][k], At[m][k], acc[ai][bj][m][n], 0, 0, 0); __builtin_amdgcn_s_setprio(0); } while (0)
#define PG8_WAIT_V(n) asm volatile("s_waitcnt vmcnt(" #n ")" ::: "memory")
#define PG8_WAIT_L(n) asm volatile("s_waitcnt lgkmcnt(" #n ")" ::: "memory")
#define PG8_BAR __builtin_amdgcn_s_barrier()
#define PG8_SCHED __builtin_amdgcn_sched_barrier(0)
#define PG8_MKA(u, v0, v1) do { _Pragma("unroll") for (int _i = 0; _i < 2; ++_i) { \
        if (GATHER) { const int _l = (u).nvalid - 1; const int _r0 = Rr[_i] < _l ? Rr[_i] : _l, _r1 = (Rr[_i] + HALF) < _l ? (Rr[_i] + HALF) : _l; \
            (v0)[_i] = (unsigned)((u).rows[_r0] * K + Cc[_i]) * 2u; (v1)[_i] = (unsigned)((u).rows[_r1] * K + Cc[_i]) * 2u; } \
        else { (v0)[_i] = (unsigned)(Rr[_i] * K + Cc[_i]) * 2u; (v1)[_i] = (v0)[_i] + (unsigned)(HALF * K * 2); } } } while (0)
    Unit cur, nxt; int ui = 0;
    if (!S.next(0, cur)) return;
    f32x4 acc[2][2][4][2];
#pragma unroll
    for (int a = 0; a < 2; ++a)
#pragma unroll
        for (int b = 0; b < 2; ++b)
#pragma unroll
            for (int m = 0; m < 4; ++m)
#pragma unroll
                for (int n = 0; n < 2; ++n) acc[a][b][m][n] = (f32x4){0.f, 0.f, 0.f, 0.f};
    bf16x8 At[4][2], B0[2][2], B1[2][2];
    const char* cA = cur.a; const char* cB = cur.b;
    unsigned vA0[2], vA1[2], nA0[2], nA1[2];
    PG8_MKA(cur, vA0, vA1);
    PG8_STAGE(PG8_SB(0, 0), cB, voffB); PG8_STAGE(PG8_SB(0, 1), cB + hstep, voffB); PG8_STAGE(PG8_SA(0, 0), cA, vA0); PG8_STAGE(PG8_SA(0, 1), cA, vA1);
    if (wr == 1) PG8_BAR;
    PG8_WAIT_V(2); PG8_BAR;
    PG8_STAGE(PG8_SB(1, 0), cB + kstep, voffB); PG8_STAGE(PG8_SA(1, 0), cA + kstep, vA0); PG8_STAGE(PG8_SB(1, 1), cB + hstep + kstep, voffB);
    PG8_WAIT_V(6); PG8_BAR;
    for (;;) {
        const bool has_next = S.next(ui + 1, nxt);
        const char* nA = has_next ? nxt.a : cA; const char* nB = has_next ? nxt.b : cB;
        if (has_next) { PG8_MKA(nxt, nA0, nA1); } else { nA0[0] = vA0[0]; nA0[1] = vA0[1]; nA1[0] = vA1[0]; nA1[1] = vA1[1]; }
        for (int t = 0; t < nt; t += 2) {
            const bool last = (t == nt - 2);
            const char* a1 = cA + (size_t)(t + 1) * kstep;
            const char* a2 = last ? nA : cA + (size_t)(t + 2) * kstep; const char* b2 = last ? nB : cB + (size_t)(t + 2) * kstep;
            const char* a3 = a2 + kstep; const char* b3 = b2 + kstep;
            unsigned x0[2], x1[2];
            x0[0] = last ? nA0[0] : vA0[0]; x0[1] = last ? nA0[1] : vA0[1]; x1[0] = last ? nA1[0] : vA1[0]; x1[1] = last ? nA1[1] : vA1[1];
            PG8_LDB(B0, 0, 0); PG8_LDB(B1, 0, 1); PG8_SCHED; PG8_LDA(At, 0, 0); PG8_STAGE(PG8_SA(1, 1), a1, vA1);
            PG8_WAIT_V(8); PG8_WAIT_L(0); PG8_BAR; PG8_MMA(0, 0, At, B0); PG8_MMA(0, 1, At, B1); PG8_BAR; PG8_SCHED;
            PG8_LDA(At, 0, 1); PG8_STAGE(PG8_SB(0, 0), b2, voffB); PG8_STAGE(PG8_SB(0, 1), b2 + hstep, voffB); PG8_STAGE(PG8_SA(0, 0), a2, x0);
            PG8_WAIT_V(8); PG8_WAIT_L(0); PG8_BAR; PG8_MMA(1, 0, At, B0); PG8_MMA(1, 1, At, B1); PG8_BAR; PG8_SCHED;
            PG8_LDB(B0, 1, 0); PG8_LDB(B1, 1, 1); PG8_SCHED; PG8_LDA(At, 1, 0); PG8_STAGE(PG8_SA(0, 1), a2, x1);
            PG8_WAIT_V(8); PG8_WAIT_L(0); PG8_BAR; PG8_MMA(0, 0, At, B0); PG8_MMA(0, 1, At, B1); PG8_BAR; PG8_SCHED;
            PG8_LDA(At, 1, 1); PG8_STAGE(PG8_SB(1, 0), b3, voffB); PG8_STAGE(PG8_SB(1, 1), b3 + hstep, voffB); PG8_STAGE(PG8_SA(1, 0), a3, x0);
            PG8_WAIT_V(8); PG8_WAIT_L(0); PG8_BAR; PG8_MMA(1, 0, At, B0); PG8_MMA(1, 1, At, B1); PG8_BAR; PG8_SCHED;
        }
        if constexpr (ALIGN_EPI) { if (wr == 0) PG8_BAR; }
        E(acc, cur, wr, wc, fr, fq);
        if (!has_next) break;
#pragma unroll
        for (int a = 0; a < 2; ++a)
#pragma unroll
            for (int b = 0; b < 2; ++b)
#pragma unroll
                for (int m = 0; m < 4; ++m)
#pragma unroll
                    for (int n = 0; n < 2; ++n) acc[a][b][m][n] = (f32x4){0.f, 0.f, 0.f, 0.f};
        cur = nxt; cA = nA; cB = nB; ++ui;
        vA0[0] = nA0[0]; vA0[1] = nA0[1]; vA1[0] = nA1[0]; vA1[1] = nA1[1];
        if constexpr (ALIGN_EPI) { if (wr == 1) PG8_BAR; }
    }
    PG8_WAIT_V(0);
    if constexpr (!ALIGN_EPI) { if (wr == 0) PG8_BAR; }
    PG8_BAR;
#undef PG8_SA
#undef PG8_SB
#undef PG8_STAGE
#undef PG8_LDA
#undef PG8_LDB
#undef PG8_MMA
#undef PG8_WAIT_V
#undef PG8_WAIT_L
#undef PG8_BAR
#undef PG8_SCHED
#undef PG8_MKA
}
}

struct StaticSched {
    const char* A; const char* Bt; int K, nM, nN, nwg, G, c;
    __device__ __forceinline__ void init(const void* A_, const void* Bt_, int Mrows, int N, int K_, int G_, int c_) { A = (const char*)A_; Bt = (const char*)Bt_; K = K_; nM = Mrows / 256; nN = N / 256; nwg = nM * nN; G = G_; c = c_; }
    __device__ __forceinline__ bool next(int i, pg8::Unit& u) const {
        const long L = (long)i * G + c; if (L >= nwg) return false;
        int wgid = (int)L; { const int q = nwg / 8, r = nwg % 8, xcd = wgid % 8, off = wgid / 8; wgid = (xcd < r ? xcd * (q + 1) : r * (q + 1) + (xcd - r) * q) + off; }
        const int nig = 8 * nN, gid = wgid / nig, fm = gid * 8, gsz = (nM - fm) < 8 ? (nM - fm) : 8;
        u.pm = fm + ((wgid % nig) % gsz); u.pn = (wgid % nig) / gsz; u.aux = 0; u.rows = nullptr; u.nvalid = 256;
        u.a = A + (size_t)u.pm * 256 * K * 2; u.b = Bt + (size_t)u.pn * 256 * K * 2; return true;
    }
};

struct EpiProj {
    static constexpr bool PERM = true;
    bf16_t* proj; const float* rc; const float* rs;
    __device__ __forceinline__ void operator()(const f32x4 (&acc)[2][2][4][2], const pg8::Unit& u, int wr, int wc, int fr, int fq) const {
        const int row0 = u.pm * 256 + wr * 64 + fr, col0 = u.pn * 256 + wc * 32 + 8 * fq;
        const int kind = (u.pn < 2) ? 1 : (u.pn < 4) ? 2 : (u.pn == 8 || u.pn == 9) ? 3 : 0;
#pragma unroll
        for (int ai = 0; ai < 2; ++ai)
#pragma unroll
            for (int m = 0; m < 4; ++m) {
                const int row = row0 + ai * 128 + m * 16; const int pos = row & (SEQ - 1);
                bf16_t* rowp = proj + (size_t)row * INW + col0;
#pragma unroll
                for (int bj = 0; bj < 2; ++bj) {
                    f32x4 v0 = acc[ai][bj][m][0], v1 = acc[ai][bj][m][1];
                    if (kind == 1 || kind == 2) {
                        const int c = col0 + bj * 128; const int d0 = (c & 63) >> 1; const int h = (c & 511) >> 6;
                        const f32x4 cs = *(const f32x4*)(rc + pos * 32 + d0), sn = *(const f32x4*)(rs + pos * 32 + d0);
                        const float lg2 = log2f(1.0f - exp2f(-5.0f - (float)h));
                        const float il = (float)(pos & (RCH - 1));
                        const float sc = (kind == 1) ? exp2f(lg2 * il) : 0.125f * exp2f(-lg2 * il);
                        f32x4 o0, o1;
                        o0[0] = (v0[0] * cs[0] - v0[1] * sn[0]) * sc; o0[1] = (v0[1] * cs[0] + v0[0] * sn[0]) * sc;
                        o0[2] = (v0[2] * cs[1] - v0[3] * sn[1]) * sc; o0[3] = (v0[3] * cs[1] + v0[2] * sn[1]) * sc;
                        o1[0] = (v1[0] * cs[2] - v1[1] * sn[2]) * sc; o1[1] = (v1[1] * cs[2] + v1[0] * sn[2]) * sc;
                        o1[2] = (v1[2] * cs[3] - v1[3] * sn[3]) * sc; o1[3] = (v1[3] * cs[3] + v1[2] * sn[3]) * sc;
                        v0 = o0; v1 = o1;
                    } else if (kind == 3) { v0 = v0 * C2; v1 = v1 * C2; }
                    u32x4 w; w.x = pg8::cvt_pk_bf16(v0[0], v0[1]); w.y = pg8::cvt_pk_bf16(v0[2], v0[3]); w.z = pg8::cvt_pk_bf16(v1[0], v1[1]); w.w = pg8::cvt_pk_bf16(v1[2], v1[3]);
                    *(u32x4*)(rowp + bj * 128) = w;
                }
            }
    }
};

template <class RowMap>
__device__ __forceinline__ void transpose64(const float* src_lane, size_t ld, bf16_t* dst_k0, int dstK, RowMap rowmap, LAS float* scr, int lane) {
#pragma unroll 16
    for (int kk = 0; kk < 64; ++kk) scr[kk * 65 + lane] = src_lane[(size_t)kk * ld];
    asm volatile("s_waitcnt lgkmcnt(0)" ::: "memory");
    const int c = lane & 7;
#pragma unroll
    for (int jj = 0; jj < 8; ++jj) {
        const int slot = (lane >> 3) + 8 * jj; const LAS float* s = scr + (8 * c) * 65 + slot;
        u32x4 o; o.x = pk2(s[0 * 65], s[1 * 65]); o.y = pk2(s[2 * 65], s[3 * 65]); o.z = pk2(s[4 * 65], s[5 * 65]); o.w = pk2(s[6 * 65], s[7 * 65]);
        *(u32x4*)(dst_k0 + (size_t)rowmap(slot) * dstK + 8 * c) = o;
    }
    asm volatile("s_waitcnt lgkmcnt(0)" ::: "memory");
}

struct EpiRes {
    static constexpr bool PERM = false;
    const float* x; const float* mod; float* x1;
    __device__ __forceinline__ void operator()(const f32x4 (&acc)[2][2][4][2], const pg8::Unit& u, int wr, int wc, int fr, int fq) const {
        const int row0 = u.pm * 256 + wr * 64 + fr, col0 = u.pn * 256 + wc * 32 + 4 * fq;
        const int b = row0 >> 12;
        f32x4 gv[2][2];
#pragma unroll
        for (int bj = 0; bj < 2; ++bj)
#pragma unroll
            for (int n = 0; n < 2; ++n) gv[bj][n] = *(const f32x4*)(mod + b * NMODW + 2 * D + col0 + bj * 128 + n * 16);
#pragma unroll
        for (int ai = 0; ai < 2; ++ai)
#pragma unroll
            for (int m = 0; m < 4; ++m) {
                const size_t off = (size_t)(row0 + ai * 128 + m * 16) * D + col0;
#pragma unroll
                for (int bj = 0; bj < 2; ++bj)
#pragma unroll
                    for (int n = 0; n < 2; ++n) {
                        const f32x4 xv = *(const f32x4*)(x + off + bj * 128 + n * 16);
                        *(f32x4*)(x1 + off + bj * 128 + n * 16) = xv + gv[bj][n] * acc[ai][bj][m][n];
                    }
                if (m & 1) asm volatile("" ::: "memory");
            }
    }
};

struct EpiHid {
    static constexpr bool PERM = true;
    bf16_t* hid; const int* list; const float* listw;
    __device__ __forceinline__ void operator()(const f32x4 (&acc)[2][2][4][2], const pg8::Unit& u, int wr, int wc, int fr, int fq) const {
        const int rl0 = wr * 64 + fr; const int f0 = u.pn * 128 + wc * 16 + fq * 4;
        const float* lw = listw + (u.rows - list);
#pragma unroll
        for (int ai = 0; ai < 2; ++ai)
#pragma unroll
            for (int m = 0; m < 4; ++m) {
                const int rl = rl0 + ai * 128 + m * 16;
                const float w = (rl < u.nvalid) ? lw[rl] : 0.f;
                bf16_t* rowp = hid + (size_t)(u.pm + rl) * DE + f0;
#pragma unroll
                for (int bj = 0; bj < 2; ++bj) {
                    const f32x4 g = acc[ai][bj][m][0], up = acc[ai][bj][m][1];
                    u32x2 o; o.x = pg8::cvt_pk_bf16(siluf(g[0]) * up[0] * w, siluf(g[1]) * up[1] * w); o.y = pg8::cvt_pk_bf16(siluf(g[2]) * up[2] * w, siluf(g[3]) * up[3] * w);
                    *(u32x2*)(rowp + bj * 64) = o;
                }
            }
    }
};

struct EpiY {
    static constexpr bool PERM = true;
    bf16_t* y;
    __device__ __forceinline__ void operator()(const f32x4 (&acc)[2][2][4][2], const pg8::Unit& u, int wr, int wc, int fr, int fq) const {
        const int rl0 = wr * 64 + fr; const int col0 = u.pn * 256 + wc * 32 + 8 * fq;
#pragma unroll
        for (int ai = 0; ai < 2; ++ai)
#pragma unroll
            for (int m = 0; m < 4; ++m) {
                bf16_t* rowp = y + (size_t)(u.pm + rl0 + ai * 128 + m * 16) * D + col0;
#pragma unroll
                for (int bj = 0; bj < 2; ++bj) {
                    const f32x4 v0 = acc[ai][bj][m][0], v1 = acc[ai][bj][m][1];
                    u32x4 w; w.x = pg8::cvt_pk_bf16(v0[0], v0[1]); w.y = pg8::cvt_pk_bf16(v0[2], v0[3]); w.z = pg8::cvt_pk_bf16(v1[0], v1[1]); w.w = pg8::cvt_pk_bf16(v1[2], v1[3]);
                    *(u32x4*)(rowp + bj * 128) = w;
                }
            }
    }
};

struct MoeSched {
    const LAS int* tab; const char* A; const char* Bt; const int* list; int K, bexp  , gather, G, c;
    __device__ __forceinline__ bool next(int i, pg8::Unit& u) const {
        const int L = i * G + c; if (L >= tab[96]) return false;
        int e = 0;
#pragma unroll 1
        for (int q = 1; q < NEXP; ++q) if (tab[64 + q] <= L) e = q;
        const int li = L - tab[64 + e], mt = li >> 2, pn = li & 3, cnt = tab[e], off = tab[32 + e];
        u.pm = off + mt * 256; u.pn = pn; u.aux = e; u.nvalid = cnt - mt * 256; u.rows = list + e * LISTCAP + mt * 256;
        u.a = gather ? A : A + (size_t)u.pm * K * 2; u.b = Bt + (size_t)e * bexp + (size_t)pn * 256 * K * 2; return true;
    }
};
__device__ __forceinline__ void moe_table(const unsigned* cnt, LAS int* tab) {
    if (threadIdx.x == 0) { int off = 0, ub = 0;
        for (int e = 0; e < NEXP; ++e) { const int c = (int)ld_cnt(cnt + e); tab[e] = c; tab[32 + e] = off; tab[64 + e] = ub; off += ((c + 255) >> 8) << 8; ub += ((c + 255) >> 8) * 4; }
        tab[96] = ub; }
    __syncthreads();
}

constexpr size_t MiB = 1u << 20;
constexpr size_t WS_MOD = 0;
constexpr size_t WS_ROPE_C = 128 * 1024;
constexpr size_t WS_ROPE_S = WS_ROPE_C + 512 * 1024;
constexpr size_t WS_CNT = WS_ROPE_S + 512 * 1024;
constexpr size_t WS_TOKSLOT = 2 * MiB;
constexpr size_t WS_LIST = 3 * MiB;
constexpr size_t WS_LISTW = 5 * MiB;
constexpr size_t WS_WIN = 8 * MiB;
constexpr size_t WS_WO = 15 * MiB;
constexpr size_t WS_WGU = 17 * MiB;
constexpr size_t WS_WD = 81 * MiB;
constexpr size_t WS_ACT = 113 * MiB;
constexpr size_t WS_PROJ = 145 * MiB;
constexpr size_t WS_HID = 145 * MiB;
constexpr size_t WS_Y = 185 * MiB;
constexpr size_t WS_END = 265 * MiB;
static_assert(WS_PROJ + (size_t)M * INW * 2 <= WS_END, "ws map");

constexpr int LDS_BYTES = 147456;
constexpr int RING_BYTES = 131072;
constexpr int TAB_OFF = 140 * 1024;

struct Params {
    const float *x, *c, *ada_w, *ada_b, *g1, *g2, *w_in, *w_out, *ret_gn, *lq1, *lk1, *lq2, *lk2, *subln;
    const float *w_group, *b_group, *w_expert, *b_expert, *w_gate, *w_up, *w_down, *final_gain;
    float* out; unsigned char* ws;
    int ph_lo, ph_hi;
};

__device__ __forceinline__ void ph_p0(const Params& p, float* sm, LAS unsigned char* lds) {
    const int tid = threadIdx.x;
    float* mod = (float*)(p.ws + WS_MOD);
    float* csil = sm;
    float* red = sm + 4096;
    for (int i = tid; i < 4096; i += NT) csil[i] = siluf(p.c[i]);
    __syncthreads();
    const int col = tid & 31, ks = tid >> 5;
    for (int it = blockIdx.x; it < NMODW / 32; it += gridDim.x) {
        const int n0 = it * 32;
        float a0 = 0.f, a1 = 0.f, a2 = 0.f, a3 = 0.f;
        for (int k = ks * 64; k < ks * 64 + 64; ++k) {
            const float w = p.ada_w[(size_t)k * NMODW + n0 + col];
            a0 += csil[k] * w; a1 += csil[1024 + k] * w; a2 += csil[2048 + k] * w; a3 += csil[3072 + k] * w;
        }
        red[(ks * 4 + 0) * 32 + col] = a0; red[(ks * 4 + 1) * 32 + col] = a1; red[(ks * 4 + 2) * 32 + col] = a2; red[(ks * 4 + 3) * 32 + col] = a3;
        __syncthreads();
        if (tid < 128) {
            const int b = tid >> 5, cc = tid & 31;
            float s = p.ada_b[n0 + cc];
            for (int q = 0; q < 16; ++q) s += red[(q * 4 + b) * 32 + cc];
            mod[b * NMODW + n0 + cc] = s;
        }
        __syncthreads();
    }
    float* rc = (float*)(p.ws + WS_ROPE_C); float* rs = (float*)(p.ws + WS_ROPE_S);
    for (int i = blockIdx.x * NT + tid; i < SEQ * 32; i += gridDim.x * NT) {
        const int pos = i >> 5, d = i & 31;
        const float inv = 1.0f / powf(10000.0f, (float)d / 32.0f);
        const float ang = (float)pos * inv;
        const double tq = (double)ang * 0.15915494309189535;
        const float fr = (float)(tq - rint(tq));
        rc[i] = __builtin_amdgcn_cosf(fr); rs[i] = __builtin_amdgcn_sinf(fr);
    }
    if (blockIdx.x == 0 && tid < 64) ((unsigned*)(p.ws + WS_CNT))[tid] = 0u;
    __syncthreads();
    const int lane = tid & 63, wave = tid >> 6;
    LAS float* scr = (LAS float*)(lds + wave * 16640);
    bf16_t* WinT = (bf16_t*)(p.ws + WS_WIN); bf16_t* WoT = (bf16_t*)(p.ws + WS_WO); bf16_t* WguT = (bf16_t*)(p.ws + WS_WGU); bf16_t* WdT = (bf16_t*)(p.ws + WS_WD);
    constexpr int I_IN = 16 * 56, I_O = 16 * 16, I_GU = NEXP * 256, I_D = NEXP * 128;
    for (int it = blockIdx.x * 8 + wave; it < I_IN + I_O + I_GU + I_D; it += gridDim.x * 8) {
        int r = it;
        if (r < I_IN) {
            const int kb = r / 56, nb = r % 56, k0 = kb * 64, n0 = nb * 64;
            transpose64(p.w_in + (size_t)k0 * INW + n0 + lane, INW, WinT + k0, D,
                        [=](int slot) { return (n0 < 1024) ? n0 + 2 * (slot & 31) + (slot >> 5) : n0 + slot; }, scr, lane);
            continue;
        }
        r -= I_IN;
        if (r < I_O) {
            const int kb = r >> 4, nb = r & 15, k0 = kb * 64, n0 = nb * 64;
            transpose64(p.w_out + (size_t)k0 * D + n0 + lane, D, WoT + k0, D, [=](int slot) { return n0 + slot; }, scr, lane);
            continue;
        }
        r -= I_O;
        if (r < I_GU) {
            const int e = r >> 8, kb = (r >> 4) & 15, fb = r & 15, k0 = kb * 64, f0 = fb * 32;
            const float* src = ((lane < 32) ? p.w_gate : p.w_up) + (size_t)e * D * DE + (size_t)k0 * DE + f0 + (lane & 31);
            transpose64(src, DE, WguT + (size_t)e * D * D + k0, D,
                        [=](int slot) { const int f = f0 + (slot & 31); return 8 * (f >> 2) + (f & 3) + 4 * (slot >> 5); }, scr, lane);
            continue;
        }
        r -= I_GU;
        {
            const int e = r >> 7, kb = (r >> 4) & 7, nb = r & 15, k0 = kb * 64, n0 = nb * 64;
            transpose64(p.w_down + (size_t)e * DE * D + (size_t)k0 * D + n0 + lane, D, WdT + (size_t)e * D * DE + k0, DE, [=](int slot) { return n0 + slot; }, scr, lane);
        }
    }
}

__device__ __forceinline__ void ph_p1(const Params& p) {
    const float* mod = (const float*)(p.ws + WS_MOD); bf16_t* h1 = (bf16_t*)(p.ws + WS_ACT);
    const int lane = threadIdx.x & 63, wave = threadIdx.x >> 6;
    for (int row = blockIdx.x * 8 + wave; row < M; row += gridDim.x * 8) {
        const int b = row >> 12;
        const float4* xr = (const float4*)(p.x + (size_t)row * D);
        float4 v[4]; float ss = 0.f;
#pragma unroll
        for (int j = 0; j < 4; ++j) { v[j] = xr[lane + 64 * j]; ss += v[j].x * v[j].x + v[j].y * v[j].y + v[j].z * v[j].z + v[j].w * v[j].w; }
        ss = wave_sum(ss);
        const float rstd = 1.0f / sqrtf(ss * (1.0f / D) + EPS);
#pragma unroll
        for (int j = 0; j < 4; ++j) {
            const int c0 = 4 * (lane + 64 * j);
            const float4 g = *(const float4*)(p.g1 + c0);
            const float4 sh = *(const float4*)(mod + b * NMODW + 0 * D + c0);
            const float4 sc = *(const float4*)(mod + b * NMODW + 1 * D + c0);
            const float o0 = v[j].x * rstd * g.x * (1.0f + sc.x) + sh.x, o1 = v[j].y * rstd * g.y * (1.0f + sc.y) + sh.y;
            const float o2 = v[j].z * rstd * g.z * (1.0f + sc.z) + sh.z, o3 = v[j].w * rstd * g.w * (1.0f + sc.w) + sh.w;
            u32x2 w; w.x = pk2(o0, o1); w.y = pk2(o2, o3);
            *(u32x2*)(h1 + (size_t)row * D + c0) = w;
        }
    }
}

__device__ __forceinline__ void ph_p2(const Params& p, LAS unsigned char* lds) {
    StaticSched S; S.init(p.ws + WS_ACT, p.ws + WS_WIN, M, INW, D, (int)gridDim.x, (int)blockIdx.x);
    EpiProj E{(bf16_t*)(p.ws + WS_PROJ), (const float*)(p.ws + WS_ROPE_C), (const float*)(p.ws + WS_ROPE_S)};
    pg8::gemm_phase<EpiProj, StaticSched, true, false>(lds, D, S, E);
}

__device__ __forceinline__ void ph_p4(const Params& p, LAS unsigned char* lds) {
    StaticSched S; S.init(p.ws + WS_ACT, p.ws + WS_WO, M, D, D, (int)gridDim.x, (int)blockIdx.x);
    EpiRes E{p.x, (const float*)(p.ws + WS_MOD), p.out};
    pg8::gemm_phase<EpiRes, StaticSched, true, false>(lds, D, S, E);
}

__device__ __forceinline__ void ph_p5(const Params& p, float* sm) {
    const float* x1 = p.out; bf16_t* h2 = (bf16_t*)(p.ws + WS_ACT);
    const float* mod = (const float*)(p.ws + WS_MOD);
    unsigned* cnt = (unsigned*)(p.ws + WS_CNT); unsigned* tokslot = (unsigned*)(p.ws + WS_TOKSLOT);
    int* list = (int*)(p.ws + WS_LIST); float* listw = (float*)(p.ws + WS_LISTW);
    const int lane = threadIdx.x & 63, wave = threadIdx.x >> 6;
    float* hrow = sm + wave * 1024;
    for (int row = blockIdx.x * 8 + wave; row < M; row += gridDim.x * 8) {
        const int b = row >> 12;
        const float4* xr = (const float4*)(x1 + (size_t)row * D);
        float4 v[4]; float ss = 0.f;
#pragma unroll
        for (int j = 0; j < 4; ++j) { v[j] = xr[lane + 64 * j]; ss += v[j].x * v[j].x + v[j].y * v[j].y + v[j].z * v[j].z + v[j].w * v[j].w; }
        ss = wave_sum(ss);
        const float rstd = 1.0f / sqrtf(ss * (1.0f / D) + EPS);
        float lg[36];
#pragma unroll
        for (int q = 0; q < 36; ++q) lg[q] = 0.f;
#pragma unroll
        for (int j = 0; j < 4; ++j) {
            const int c0 = 4 * (lane + 64 * j);
            const float4 g = *(const float4*)(p.g2 + c0);
            const float4 sh = *(const float4*)(mod + b * NMODW + 3 * D + c0);
            const float4 sc = *(const float4*)(mod + b * NMODW + 4 * D + c0);
            float4 hv;
            hv.x = v[j].x * rstd * g.x * (1.0f + sc.x) + sh.x; hv.y = v[j].y * rstd * g.y * (1.0f + sc.y) + sh.y;
            hv.z = v[j].z * rstd * g.z * (1.0f + sc.z) + sh.z; hv.w = v[j].w * rstd * g.w * (1.0f + sc.w) + sh.w;
            *(float4*)(hrow + c0) = hv;
            u32x2 w; w.x = pk2(hv.x, hv.y); w.y = pk2(hv.z, hv.w);
            *(u32x2*)(h2 + (size_t)row * D + c0) = w;
        }
#pragma unroll 1
        for (int kk = 0; kk < 16; ++kk) {
            const int k = 4 * (lane + 64 * (kk >> 2)) + (kk & 3);
            const float hvk = hrow[k];
            const float4 wg = *(const float4*)(p.w_group + (size_t)k * 4);
            lg[0] += hvk * wg.x; lg[1] += hvk * wg.y; lg[2] += hvk * wg.z; lg[3] += hvk * wg.w;
#pragma unroll
            for (int q = 0; q < 8; ++q) {
                const float4 we = *(const float4*)(p.w_expert + (size_t)k * 32 + q * 4);
                lg[4 + q * 4 + 0] += hvk * we.x; lg[4 + q * 4 + 1] += hvk * we.y; lg[4 + q * 4 + 2] += hvk * we.z; lg[4 + q * 4 + 3] += hvk * we.w;
            }
        }
#pragma unroll
        for (int q = 0; q < 36; ++q) lg[q] = wave_sum(lg[q]);
        if (lane == 0) {
            float gl[4]; int gi = 0;
#pragma unroll
            for (int q = 0; q < 4; ++q) gl[q] = lg[q] + p.b_group[q];
            float gmax = gl[0];
#pragma unroll
            for (int q = 1; q < 4; ++q) if (gl[q] > gmax) { gmax = gl[q]; gi = q; }
            float den = 0.f;
#pragma unroll
            for (int q = 0; q < 4; ++q) den += expf(gl[q] - gmax);
            const float gw = 1.0f / den;
            float el[8];
#pragma unroll
            for (int q = 0; q < 8; ++q) {
                float vsel = lg[4 + q];
                if (gi == 1) vsel = lg[4 + 8 + q]; else if (gi == 2) vsel = lg[4 + 16 + q]; else if (gi == 3) vsel = lg[4 + 24 + q];
                el[q] = vsel + p.b_expert[gi * 8 + q];
            }
            int i1 = 0; float v1 = el[0];
#pragma unroll
            for (int q = 1; q < 8; ++q) if (el[q] > v1) { v1 = el[q]; i1 = q; }
            int i2 = -1; float v2 = -INFINITY;
#pragma unroll
            for (int q = 0; q < 8; ++q) if (q != i1 && el[q] > v2) { v2 = el[q]; i2 = q; }
            if (i2 < 0) { i2 = (i1 == 0) ? 1 : 0; v2 = v1; }
            const float e2 = expf(v2 - v1);
            const float w1 = gw / (1.0f + e2), w2 = gw * e2 / (1.0f + e2);
            const int ea = gi * 8 + i1, eb = gi * 8 + i2;
            const unsigned pa = atomicAdd(&cnt[ea], 1u), pb = atomicAdd(&cnt[eb], 1u);
            list[ea * LISTCAP + pa] = row; listw[ea * LISTCAP + pa] = w1;
            list[eb * LISTCAP + pb] = row; listw[eb * LISTCAP + pb] = w2;
            tokslot[row * 2 + 0] = ((unsigned)ea << 16) | pa; tokslot[row * 2 + 1] = ((unsigned)eb << 16) | pb;
        }
    }
}

__device__ __forceinline__ void ph_p6(const Params& p, LAS unsigned char* lds) {
    LAS int* tab = (LAS int*)(lds + TAB_OFF);
    moe_table((const unsigned*)(p.ws + WS_CNT), tab);
    const int G = (int)gridDim.x, bx = (int)blockIdx.x, vc = (G % 8 == 0) ? (bx % 8) * (G / 8) + bx / 8 : bx;
    MoeSched S{tab, (const char*)(p.ws + WS_ACT), (const char*)(p.ws + WS_WGU), (const int*)(p.ws + WS_LIST), D, D * D * 2, 1, G, vc};
    EpiHid E{(bf16_t*)(p.ws + WS_HID), (const int*)(p.ws + WS_LIST), (const float*)(p.ws + WS_LISTW)};
    pg8::gemm_phase<EpiHid, MoeSched, true, true>(lds, D, S, E);
}

__device__ __forceinline__ void ph_p7(const Params& p, LAS unsigned char* lds) {
    LAS int* tab = (LAS int*)(lds + TAB_OFF);
    moe_table((const unsigned*)(p.ws + WS_CNT), tab);
    const int G = (int)gridDim.x, bx = (int)blockIdx.x, vc = (G % 8 == 0) ? (bx % 8) * (G / 8) + bx / 8 : bx;
    MoeSched S{tab, (const char*)(p.ws + WS_HID), (const char*)(p.ws + WS_WD), (const int*)(p.ws + WS_LIST), DE, D * DE * 2, 0, G, vc};
    EpiY E{(bf16_t*)(p.ws + WS_Y)};
    pg8::gemm_phase<EpiY, MoeSched, true, false>(lds, DE, S, E);
}

__device__ __forceinline__ void ph_p8(const Params& p, LAS unsigned char* lds) {
    LAS int* tab = (LAS int*)(lds + TAB_OFF);
    moe_table((const unsigned*)(p.ws + WS_CNT), tab);
    const float* mod = (const float*)(p.ws + WS_MOD); const bf16_t* y = (const bf16_t*)(p.ws + WS_Y); const unsigned* tokslot = (const unsigned*)(p.ws + WS_TOKSLOT);
    const int lane = threadIdx.x & 63, wave = threadIdx.x >> 6;
    for (int row = blockIdx.x * 8 + wave; row < M; row += gridDim.x * 8) {
        const int b = row >> 12;
        const unsigned s0 = tokslot[row * 2], s1 = tokslot[row * 2 + 1];
        const size_t r0 = (size_t)(tab[32 + (s0 >> 16)] + (int)(s0 & 0xffffu)), r1 = (size_t)(tab[32 + (s1 >> 16)] + (int)(s1 & 0xffffu));
        float4 v[4]; float ss = 0.f;
#pragma unroll
        for (int j = 0; j < 4; ++j) {
            const int c0 = 4 * (lane + 64 * j);
            const float4 a = *(const float4*)(p.out + (size_t)row * D + c0), g = *(const float4*)(mod + b * NMODW + 5 * D + c0);
            const u32x2 ya = *(const u32x2*)(y + r0 * D + c0), yb = *(const u32x2*)(y + r1 * D + c0);
            v[j].x = a.x + g.x * (bflo(ya.x) + bflo(yb.x)); v[j].y = a.y + g.y * (bfhi(ya.x) + bfhi(yb.x));
            v[j].z = a.z + g.z * (bflo(ya.y) + bflo(yb.y)); v[j].w = a.w + g.w * (bfhi(ya.y) + bfhi(yb.y));
            ss += v[j].x * v[j].x + v[j].y * v[j].y + v[j].z * v[j].z + v[j].w * v[j].w;
        }
        ss = wave_sum(ss);
        const float rstd = 1.0f / sqrtf(ss * (1.0f / D) + EPS);
#pragma unroll
        for (int j = 0; j < 4; ++j) {
            const int c0 = 4 * (lane + 64 * j);
            const float4 g = *(const float4*)(p.final_gain + c0);
            *(float4*)(p.out + (size_t)row * D + c0) = make_float4(v[j].x * rstd * g.x, v[j].y * rstd * g.y, v[j].z * rstd * g.z, v[j].w * rstd * g.w);
        }
    }
}

namespace ret {
typedef short v4i16_t __attribute__((ext_vector_type(4)));
constexpr int NPART = 8, CP = 32 / NPART;
constexpr int TQ = 16384, BUFB = 3 * TQ;
constexpr int Y_OFF = 2 * BUFB, YLD = 68;
constexpr int LDS_NEED = Y_OFF + 128 * YLD * 4;
__device__ __forceinline__ int crow(int r, int hi) { return (r & 3) + 8 * (r >> 2) + 4 * hi; }
__device__ __forceinline__ unsigned cvtpk(float lo, float hi) { typedef float f32x2_t __attribute__((ext_vector_type(2))); typedef __bf16 bf16x2_t __attribute__((ext_vector_type(2))); f32x2_t v = {lo, hi}; bf16x2_t b = __builtin_convertvector(v, bf16x2_t); return __builtin_bit_cast(unsigned, b); }
#define RT_TR(p) __builtin_amdgcn_ds_read_tr16_b64_v4i16((LAS v4i16_t*)(p))

__device__ __forceinline__ void unit(const bf16_t* proj, bf16_t* mix, const float* gn, int b, int h, int part, LAS unsigned char* lds) {
    const int tid = threadIdx.x, lane = tid & 63, r32 = lane & 31, hi = lane >> 5;
    const int wid = __builtin_amdgcn_readfirstlane(tid >> 6), a = wid & 3, dblk = wid >> 2;
    const size_t tb = (size_t)b * SEQ;
    const float lg2 = log2f(1.0f - exp2f(-5.0f - (float)h));
    const float gC = exp2f((float)RCH * lg2);
    const int n_pre = part * CP, total = n_pre + CP;
    const bf16_t* qsrc = proj + (tb + lane) * INW + OFF_RQ + h * 64 + wid * 8;
    const bf16_t* ksrc = proj + (tb + lane) * INW + OFF_RK + h * 64 + wid * 8;
    const bf16_t* vsrc = proj + (tb + 16 * wid + (lane >> 2)) * INW + OFF_RV + h * 64 + (lane & 3) * 8;
#define RT_GLDS(src, dstoff) __builtin_amdgcn_global_load_lds((const unsigned*)(src), (LAS unsigned*)(lds + (dstoff)), 16, 0, 0)
#define RT_ISSUE(ci, bo, withq) do { const size_t _o = (size_t)(ci) * RCH * INW; \
        if (withq) { RT_GLDS(qsrc + _o, (bo) + wid * 2048); RT_GLDS(qsrc + _o + (size_t)64 * INW, (bo) + wid * 2048 + 1024); } \
        RT_GLDS(ksrc + _o, (bo) + TQ + wid * 2048); RT_GLDS(ksrc + _o + (size_t)64 * INW, (bo) + TQ + wid * 2048 + 1024); \
        RT_GLDS(vsrc + _o, (bo) + 2 * TQ + wid * 1024); RT_GLDS(vsrc + _o + 32, (bo) + 2 * TQ + 8192 + wid * 1024); } while (0)
    f32x16 T[2];
#pragma unroll
    for (int kb = 0; kb < 2; ++kb)
#pragma unroll
        for (int r = 0; r < 16; ++r) T[kb][r] = 0.f;
    const int vofs = 2 * TQ + dblk * 8192 + ((lane >> 4) & 1) * 32 + (lane & 3) * 8 + (4 * hi + ((lane & 15) >> 2)) * 64;
    const int g16 = (lane >> 4) & 1, q4 = (lane & 15) >> 2, p4 = lane & 3;
    const int ktofs = TQ + (2 * g16 + (p4 >> 1)) * 2048 + (4 * hi + q4) * 16 + (p4 & 1) * 8;
    const int rowofs = (32 * a + r32) * 16;
    RT_ISSUE(0, 0, (n_pre == 0));
    for (int ci = 0; ci < total; ++ci) {
        const int bo = (ci & 1) * BUFB;
        const bool outp = (ci >= n_pre);
        asm volatile("s_waitcnt vmcnt(0)" ::: "memory");
        __builtin_amdgcn_s_barrier();
        asm volatile("" ::: "memory");
        if (ci + 1 < total) RT_ISSUE(ci + 1, BUFB - bo, (ci + 1 >= n_pre));
        if (outp) {
            f32x16 o;
#pragma unroll
            for (int r = 0; r < 16; ++r) o[r] = 0.f;
#pragma unroll
            for (int kb = 0; kb < 2; ++kb)
#pragma unroll
                for (int s = 0; s < 2; ++s) {
                    const u32x2 qa = *(const LAS u32x2*)(lds + bo + (4 * kb + 2 * s) * 2048 + rowofs + 8 * hi);
                    const u32x2 qb = *(const LAS u32x2*)(lds + bo + (4 * kb + 2 * s + 1) * 2048 + rowofs + 8 * hi);
                    const u32x4 af = (u32x4){qa.x, qa.y, qb.x, qb.y};
                    const u32x4 bf = (u32x4){cvtpk(T[kb][8 * s + 0], T[kb][8 * s + 1]), cvtpk(T[kb][8 * s + 2], T[kb][8 * s + 3]), cvtpk(T[kb][8 * s + 4], T[kb][8 * s + 5]), cvtpk(T[kb][8 * s + 6], T[kb][8 * s + 7])};
                    o = __builtin_amdgcn_mfma_f32_32x32x16_bf16(__builtin_bit_cast(bf16x8, af), __builtin_bit_cast(bf16x8, bf), o, 0, 0, 0);
                }
#pragma unroll
            for (int r = 0; r < 16; ++r) o[r] *= gC;
            bf16x8 qr[4];
#pragma unroll
            for (int d0 = 0; d0 < 4; ++d0) qr[d0] = *(const LAS bf16x8*)(lds + bo + (2 * d0 + hi) * 2048 + rowofs);
            for (int jb = 0; jb <= a; ++jb) {
                f32x16 s;
#pragma unroll
                for (int r = 0; r < 16; ++r) s[r] = 0.f;
#pragma unroll
                for (int d0 = 0; d0 < 4; ++d0) {
                    const bf16x8 kf = *(const LAS bf16x8*)(lds + bo + TQ + (2 * d0 + hi) * 2048 + (32 * jb + r32) * 16);
                    s = __builtin_amdgcn_mfma_f32_32x32x16_bf16(kf, qr[d0], s, 0, 0, 0);
                }
                if (jb == a) {
#pragma unroll
                    for (int r = 0; r < 16; ++r) if (crow(r, hi) > r32) s[r] = 0.f;
                }
                const u32x4 pa0 = (u32x4){cvtpk(s[0], s[1]), cvtpk(s[2], s[3]), cvtpk(s[4], s[5]), cvtpk(s[6], s[7])};
                const u32x4 pa1 = (u32x4){cvtpk(s[8], s[9]), cvtpk(s[10], s[11]), cvtpk(s[12], s[13]), cvtpk(s[14], s[15])};
                {
                    const v4i16_t lo = RT_TR(lds + bo + vofs + (2 * jb) * 1024), hv = RT_TR(lds + bo + vofs + (2 * jb) * 1024 + 512);
                    const bf16x8 vf = (bf16x8){lo[0], lo[1], lo[2], lo[3], hv[0], hv[1], hv[2], hv[3]};
                    o = __builtin_amdgcn_mfma_f32_32x32x16_bf16(__builtin_bit_cast(bf16x8, pa0), vf, o, 0, 0, 0);
                }
                {
                    const v4i16_t lo = RT_TR(lds + bo + vofs + (2 * jb + 1) * 1024), hv = RT_TR(lds + bo + vofs + (2 * jb + 1) * 1024 + 512);
                    const bf16x8 vf = (bf16x8){lo[0], lo[1], lo[2], lo[3], hv[0], hv[1], hv[2], hv[3]};
                    o = __builtin_amdgcn_mfma_f32_32x32x16_bf16(__builtin_bit_cast(bf16x8, pa1), vf, o, 0, 0, 0);
                }
            }
            LAS float* Y = (LAS float*)(lds + Y_OFF);
#pragma unroll
            for (int r = 0; r < 16; ++r) Y[(32 * a + crow(r, hi)) * YLD + 32 * dblk + r32] = o[r];
        }
        if (ci + 1 < total) {
#pragma unroll
            for (int kb = 0; kb < 2; ++kb)
#pragma unroll
                for (int r = 0; r < 16; ++r) T[kb][r] *= gC;
#pragma unroll
            for (int ts = 0; ts < 8; ++ts) {
                const v4i16_t vlo = RT_TR(lds + bo + vofs + ts * 1024), vhv = RT_TR(lds + bo + vofs + ts * 1024 + 512);
                const bf16x8 vf = (bf16x8){vlo[0], vlo[1], vlo[2], vlo[3], vhv[0], vhv[1], vhv[2], vhv[3]};
#pragma unroll
                for (int kb = 0; kb < 2; ++kb) {
                    const v4i16_t klo = RT_TR(lds + bo + ktofs + kb * 8192 + ts * 256), khv = RT_TR(lds + bo + ktofs + kb * 8192 + ts * 256 + 128);
                    const bf16x8 kf = (bf16x8){klo[0], klo[1], klo[2], klo[3], khv[0], khv[1], khv[2], khv[3]};
                    T[kb] = __builtin_amdgcn_mfma_f32_32x32x16_bf16(kf, vf, T[kb], 0, 0, 0);
                }
            }
        }
        if (outp) {
            asm volatile("s_waitcnt lgkmcnt(0)" ::: "memory");
            __builtin_amdgcn_s_barrier();
            asm volatile("" ::: "memory");
            const int row = tid >> 2, qd = tid & 3;
            const LAS float* yr = (const LAS float*)(lds + Y_OFF) + row * YLD + 16 * qd;
            float v[16];
#pragma unroll
            for (int i = 0; i < 4; ++i) { const f32x4 t4 = *(const LAS f32x4*)(yr + 4 * i); v[4 * i] = t4[0]; v[4 * i + 1] = t4[1]; v[4 * i + 2] = t4[2]; v[4 * i + 3] = t4[3]; }
            float s1 = 0.f;
#pragma unroll
            for (int i = 0; i < 16; ++i) s1 += v[i];
            s1 += __shfl_xor(s1, 1); s1 += __shfl_xor(s1, 2);
            const float mu = s1 * (1.0f / 64.0f);
            float s2 = 0.f;
#pragma unroll
            for (int i = 0; i < 16; ++i) { v[i] -= mu; s2 += v[i] * v[i]; }
            s2 += __shfl_xor(s2, 1); s2 += __shfl_xor(s2, 2);
            const float rstd = 1.0f / sqrtf(s2 * (1.0f / 64.0f) + EPS);
            const size_t t = tb + (size_t)ci * RCH + row;
            const u32x4 g0 = *(const u32x4*)(proj + t * INW + OFF_RG + h * 64 + 16 * qd), g1 = *(const u32x4*)(proj + t * INW + OFF_RG + h * 64 + 16 * qd + 8);
            const unsigned gw[8] = {g0.x, g0.y, g0.z, g0.w, g1.x, g1.y, g1.z, g1.w};
            unsigned ow[8];
#pragma unroll
            for (int i = 0; i < 8; ++i) {
                const float ga = bflo(gw[i]), gb = bfhi(gw[i]);
                const float oa = v[2 * i] * rstd * gn[h * 64 + 16 * qd + 2 * i] * siluf(ga), ob = v[2 * i + 1] * rstd * gn[h * 64 + 16 * qd + 2 * i + 1] * siluf(gb);
                ow[i] = cvtpk(oa, ob);
            }
            *(u32x4*)(mix + t * D + h * 64 + 16 * qd) = (u32x4){ow[0], ow[1], ow[2], ow[3]};
            *(u32x4*)(mix + t * D + h * 64 + 16 * qd + 8) = (u32x4){ow[4], ow[5], ow[6], ow[7]};
        }
    }
    asm volatile("s_waitcnt lgkmcnt(0)" ::: "memory");
    __builtin_amdgcn_s_barrier();
    asm volatile("" ::: "memory");
#undef RT_GLDS
#undef RT_ISSUE
}
#undef RT_TR
}

__device__ __forceinline__ void ph_ret(const Params& p, LAS unsigned char* lds) {
    const bf16_t* proj = (const bf16_t*)(p.ws + WS_PROJ); bf16_t* mix = (bf16_t*)(p.ws + WS_ACT);
    for (int u = blockIdx.x; u < 32 * ret::NPART; u += gridDim.x) {
        const int bh = u & 31, part = u >> 5;
        ret::unit(proj, mix, p.ret_gn, bh >> 3, bh & 7, part, lds);
    }
}

namespace dattn {
typedef short v4i16_t __attribute__((ext_vector_type(4)));
constexpr int KB_BYTES = 8192, VB_BYTES = 16384, BUF_BYTES = 2 * KB_BYTES + VB_BYTES;
constexpr int WSF_OFF = 2 * BUF_BYTES;
constexpr int LDS_NEED = WSF_OFF + 8 * 64 * 4;
__device__ __forceinline__ int crow(int r, int hi) { return (r & 3) + 8 * (r >> 2) + 4 * hi; }
__device__ __forceinline__ unsigned cvtpk(float lo, float hi) { typedef float f32x2_t __attribute__((ext_vector_type(2))); typedef __bf16 bf16x2_t __attribute__((ext_vector_type(2))); f32x2_t v = {lo, hi}; bf16x2_t b = __builtin_convertvector(v, bf16x2_t); return __builtin_bit_cast(unsigned, b); }

__device__ __forceinline__ void unit(const bf16_t* proj, bf16_t* mix, const float* subln, float lam, int b, int h, int qb, LAS unsigned char* lds) {
    const int tid = threadIdx.x, lane = tid & 63, r32 = lane & 31, hi = lane >> 5;
    const int wid = __builtin_amdgcn_readfirstlane(tid >> 6), mp = wid >> 2, rblk = wid & 3;
    const size_t tb = (size_t)b * SEQ; const int q0 = qb * 128;
    const int NTL = 2 * (qb + 1);
    const bf16_t* Kg = proj + tb * INW + OFF_DK + h * 128;
    const bf16_t* Vg = proj + tb * INW + OFF_DV + h * 128;
    const bf16_t* ksrc0 = Kg + (size_t)lane * INW + wid * 8;
    const bf16_t* ksrc1 = ksrc0 + 64;
    const bf16_t* vsrcA = Vg + (size_t)(16 * (wid & 3) + (lane >> 2)) * INW + (wid >> 2) * 32 + (lane & 3) * 8;
    const bf16_t* vsrcB = vsrcA + 64;
    LAS float* wsf = (LAS float*)(lds + WSF_OFF) + wid * 64;
#define DA_ISSUE(t, bo) do { const size_t _o = (size_t)(t) * 64 * INW; \
        __builtin_amdgcn_global_load_lds((const unsigned*)(ksrc0 + _o), (LAS unsigned*)(lds + (bo) + wid * 1024), 16, 0, 0); \
        __builtin_amdgcn_global_load_lds((const unsigned*)(ksrc1 + _o), (LAS unsigned*)(lds + (bo) + KB_BYTES + wid * 1024), 16, 0, 0); \
        __builtin_amdgcn_global_load_lds((const unsigned*)(vsrcA + _o), (LAS unsigned*)(lds + (bo) + 2 * KB_BYTES + wid * 1024), 16, 0, 0); \
        __builtin_amdgcn_global_load_lds((const unsigned*)(vsrcB + _o), (LAS unsigned*)(lds + (bo) + 2 * KB_BYTES + 8192 + wid * 1024), 16, 0, 0); } while (0)
    DA_ISSUE(0, 0);
    const bf16_t* Qw = proj + (tb + q0 + rblk * 32 + r32) * INW + OFF_DQ + h * 128 + mp * 64 + hi * 8;
    bf16x8 qr[4];
#pragma unroll
    for (int d0 = 0; d0 < 4; ++d0) qr[d0] = *(const bf16x8*)(Qw + d0 * 16);
    f32x16 o[4];
#pragma unroll
    for (int d0 = 0; d0 < 4; ++d0)
#pragma unroll
        for (int r = 0; r < 16; ++r) o[d0][r] = 0.f;
    float mrun = -INFINITY, lrun = 0.f;
    const int qrow = q0 + rblk * 32 + r32;
    const int kofs = mp * KB_BYTES + hi * 1024 + r32 * 16;
    const int vofs = 2 * KB_BYTES + ((lane >> 4) & 1) * 32 + (lane & 3) * 8 + (4 * hi + ((lane & 15) >> 2)) * 64;
    for (int t = 0; t < NTL; ++t) {
        const int bo = (t & 1) * BUF_BYTES;
        asm volatile("s_waitcnt vmcnt(0)" ::: "memory");
        __builtin_amdgcn_s_barrier();
        asm volatile("" ::: "memory");
        if (t + 1 < NTL) DA_ISSUE(t + 1, BUF_BYTES - bo);
        f32x16 p0, p1;
#pragma unroll
        for (int r = 0; r < 16; ++r) { p0[r] = 0.f; p1[r] = 0.f; }
#pragma unroll
        for (int d0 = 0; d0 < 4; ++d0) {
            const bf16x8 k0 = *(const LAS bf16x8*)(lds + bo + kofs + d0 * 2048);
            const bf16x8 k1 = *(const LAS bf16x8*)(lds + bo + kofs + d0 * 2048 + 512);
            p0 = __builtin_amdgcn_mfma_f32_32x32x16_bf16(k0, qr[d0], p0, 0, 0, 0);
            p1 = __builtin_amdgcn_mfma_f32_32x32x16_bf16(k1, qr[d0], p1, 0, 0, 0);
        }
        const int j0 = t * 64;
        if (t >= NTL - 2) {
#pragma unroll
            for (int r = 0; r < 16; ++r) { const int kv = j0 + crow(r, hi); if (kv > qrow) p0[r] = -INFINITY; if (kv + 32 > qrow) p1[r] = -INFINITY; }
        }
        float rm = fmaxf(p0[0], p1[0]);
#pragma unroll
        for (int r = 1; r < 16; ++r) rm = fmaxf(rm, fmaxf(p0[r], p1[r]));
        rm = fmaxf(rm, __shfl_xor(rm, 32));
        const float mnew = fmaxf(mrun, rm);
        const float alpha = __builtin_amdgcn_exp2f(mrun - mnew);
        mrun = mnew;
        float ps = 0.f;
#pragma unroll
        for (int r = 0; r < 16; ++r) { p0[r] = __builtin_amdgcn_exp2f(p0[r] - mnew); p1[r] = __builtin_amdgcn_exp2f(p1[r] - mnew); ps += p0[r] + p1[r]; }
        lrun = lrun * alpha + ps;
        if (hi == 0) wsf[r32] = alpha;
        asm volatile("s_waitcnt lgkmcnt(0)" ::: "memory");
        float al[16];
#pragma unroll
        for (int r = 0; r < 16; ++r) al[r] = wsf[crow(r, hi)];
#pragma unroll
        for (int d0 = 0; d0 < 4; ++d0)
#pragma unroll
            for (int r = 0; r < 16; ++r) o[d0][r] *= al[r];
        u32x4 pw[4];
        pw[0] = (u32x4){cvtpk(p0[0], p0[1]), cvtpk(p0[2], p0[3]), cvtpk(p0[4], p0[5]), cvtpk(p0[6], p0[7])};
        pw[1] = (u32x4){cvtpk(p0[8], p0[9]), cvtpk(p0[10], p0[11]), cvtpk(p0[12], p0[13]), cvtpk(p0[14], p0[15])};
        pw[2] = (u32x4){cvtpk(p1[0], p1[1]), cvtpk(p1[2], p1[3]), cvtpk(p1[4], p1[5]), cvtpk(p1[6], p1[7])};
        pw[3] = (u32x4){cvtpk(p1[8], p1[9]), cvtpk(p1[10], p1[11]), cvtpk(p1[12], p1[13]), cvtpk(p1[14], p1[15])};
#pragma unroll
        for (int d0 = 0; d0 < 4; ++d0)
#pragma unroll
            for (int ks = 0; ks < 4; ++ks) {
                const v4i16_t lo = __builtin_amdgcn_ds_read_tr16_b64_v4i16((LAS v4i16_t*)(lds + bo + vofs + d0 * 4096 + ks * 1024));
                const v4i16_t hv = __builtin_amdgcn_ds_read_tr16_b64_v4i16((LAS v4i16_t*)(lds + bo + vofs + d0 * 4096 + ks * 1024 + 512));
                const bf16x8 vf = (bf16x8){lo[0], lo[1], lo[2], lo[3], hv[0], hv[1], hv[2], hv[3]};
                o[d0] = __builtin_amdgcn_mfma_f32_32x32x16_bf16(__builtin_bit_cast(bf16x8, pw[ks]), vf, o[d0], 0, 0, 0);
            }
    }
    lrun += __shfl_xor(lrun, 32);
    if (hi == 0) wsf[32 + r32] = 1.0f / lrun;
    asm volatile("s_waitcnt lgkmcnt(0)" ::: "memory");
    float rl[16];
#pragma unroll
    for (int r = 0; r < 16; ++r) rl[r] = wsf[32 + crow(r, hi)];
#pragma unroll
    for (int d0 = 0; d0 < 4; ++d0)
#pragma unroll
        for (int r = 0; r < 16; ++r) o[d0][r] *= rl[r];
    asm volatile("s_waitcnt lgkmcnt(0)" ::: "memory");
    __builtin_amdgcn_s_barrier();
    asm volatile("" ::: "memory");
    LAS float* X = (LAS float*)lds + rblk * 4096;
    if (mp == 1) {
#pragma unroll
        for (int d0 = 0; d0 < 4; ++d0)
#pragma unroll
            for (int r = 0; r < 16; ++r) X[(d0 * 16 + r) * 64 + lane] = o[d0][r];
    }
    asm volatile("s_waitcnt lgkmcnt(0)" ::: "memory");
    __builtin_amdgcn_s_barrier();
    asm volatile("" ::: "memory");
    if (mp == 0) {
        float ss[16];
#pragma unroll
        for (int r = 0; r < 16; ++r) ss[r] = 0.f;
#pragma unroll
        for (int d0 = 0; d0 < 4; ++d0)
#pragma unroll
            for (int r = 0; r < 16; ++r) { const float dv = o[d0][r] - lam * X[(d0 * 16 + r) * 64 + lane]; o[d0][r] = dv; ss[r] += dv * dv; }
#pragma unroll
        for (int r = 0; r < 16; ++r) {
            float s = ss[r];
            s += __shfl_xor(s, 1); s += __shfl_xor(s, 2); s += __shfl_xor(s, 4); s += __shfl_xor(s, 8); s += __shfl_xor(s, 16);
            ss[r] = (1.0f - LAMBDA_INIT) / sqrtf(s * (1.0f / 128.0f) + EPS);
        }
        bf16_t* mrow = mix + (tb + q0 + rblk * 32) * D + 512 + h * 128 + r32;
#pragma unroll
        for (int d0 = 0; d0 < 4; ++d0) {
            const float g = subln[d0 * 32 + r32];
#pragma unroll
            for (int r = 0; r < 16; ++r) mrow[(size_t)crow(r, hi) * D + d0 * 32] = (bf16_t)f2bf(o[d0][r] * ss[r] * g);
        }
    }
    asm volatile("s_waitcnt lgkmcnt(0)" ::: "memory");
    __builtin_amdgcn_s_barrier();
    asm volatile("" ::: "memory");
#undef DA_ISSUE
}
}

__device__ __forceinline__ void ph_attn(const Params& p, LAS unsigned char* lds) {
    float lam;
    { float a = 0.f, bq = 0.f; for (int i = 0; i < 64; ++i) { a += p.lq1[i] * p.lk1[i]; bq += p.lq2[i] * p.lk2[i]; } lam = expf(a) - expf(bq) + LAMBDA_INIT; }
    const bf16_t* proj = (const bf16_t*)(p.ws + WS_PROJ); bf16_t* mix = (bf16_t*)(p.ws + WS_ACT);
    for (int k = 2 * (int)blockIdx.x; k < 512; k += 2 * (int)gridDim.x)
        for (int half = 0; half < 2; ++half) {
            const int uu = half ? 511 - (k >> 1) : (k >> 1);
            const int qb = 31 - uu / 16, bh = uu % 16;
            dattn::unit(proj, mix, p.subln, lam, bh >> 2, bh & 3, qb, lds);
        }
}
constexpr int NPHASE = 9;

__global__ void __launch_bounds__(NT, 2) mega(Params p) {
    extern __shared__ __attribute__((aligned(16))) unsigned char lds_raw[];
    float* sm = (float*)lds_raw;
    LAS unsigned char* lds = (LAS unsigned char*)lds_raw;
    cg::grid_group grid = cg::this_grid();
#define PH(k) (p.ph_lo <= (k) && (k) < p.ph_hi)
#define SYNC(k) do { if (PH(k) && PH((k) + 1)) grid.sync(); } while (0)
    if (PH(0)) ph_p0(p, sm, lds);
    SYNC(0);
    if (PH(1)) ph_p1(p);
    SYNC(1);
    if (PH(2)) ph_p2(p, lds);
    SYNC(2);
    if (PH(3)) { ph_ret(p, lds); ph_attn(p, lds); }
    SYNC(3);
    if (PH(4)) ph_p4(p, lds);
    SYNC(4);
    if (PH(5)) ph_p5(p, sm);
    SYNC(5);
    if (PH(6)) ph_p6(p, lds);
    SYNC(6);
    if (PH(7)) ph_p7(p, lds);
    SYNC(7);
    if (PH(8)) ph_p8(p, lds);
#undef PH
#undef SYNC
}

#ifndef N_LAUNCHES
#define N_LAUNCHES 1
#endif

extern "C" void kernel_launch(void* const* d_in, const int* in_sizes, int n_in, void* d_out, int out_size, void* d_ws, size_t ws_size, hipStream_t stream) {
    static int grid = 0;
    if (grid == 0) {
        if (n_in != 22 || in_sizes[0] != M * D || out_size != M * D || ws_size < WS_END) {
            fprintf(stderr, "kernel_launch: unexpected shapes (n_in %d, in0 %d, out %d, ws %zu)\n", n_in, n_in > 0 ? in_sizes[0] : -1, out_size, ws_size); grid = -1; return; }
        int dev = 0, cus = 0, per_cu = 0;
        (void)hipGetDevice(&dev);
        (void)hipDeviceGetAttribute(&cus, hipDeviceAttributeMultiprocessorCount, dev);
        (void)hipFuncSetAttribute((const void*)mega, hipFuncAttributeMaxDynamicSharedMemorySize, LDS_BYTES);
        (void)hipOccupancyMaxActiveBlocksPerMultiprocessor(&per_cu, (const void*)mega, NT, LDS_BYTES);
        if (per_cu < 1) { fprintf(stderr, "kernel_launch: occupancy query says %d\n", per_cu); grid = -1; return; }
        grid = cus;
    }
    if (grid < 0) return;
    Params p{};
    const float** f = (const float**)&p;
    for (int i = 0; i < 22; ++i) f[i] = (const float*)d_in[i];
    p.out = (float*)d_out; p.ws = (unsigned char*)d_ws;
    if (N_LAUNCHES == 1) {
        p.ph_lo = 0; p.ph_hi = NPHASE;
        void* args[] = {&p};
        hipError_t e = hipLaunchCooperativeKernel((void*)mega, dim3(grid), dim3(NT), args, LDS_BYTES, stream);
        if (e != hipSuccess) fprintf(stderr, "cooperative launch failed: %s (grid %d)\n", hipGetErrorString(e), grid);
    } else {
        for (int k = 0; k < NPHASE; ++k) { p.ph_lo = k; p.ph_hi = k + 1; hipLaunchKernelGGL(mega, dim3(grid), dim3(NT), LDS_BYTES, stream, p); }
    }
}
```

```cpp
#include <hip/hip_runtime.h>
#include <hip/hip_cooperative_groups.h>
#include <cstdio>
#include <cstdint>
#include <cmath>
namespace cg = cooperative_groups;

constexpr int D = 1024, NB = 4, SEQ = 4096, M = NB * SEQ;
constexpr int INW = 3584;
constexpr int OFF_RQ = 0, OFF_RK = 512, OFF_RV = 1024, OFF_RG = 1536, OFF_DQ = 2048, OFF_DK = 2560, OFF_DV = 3072;
constexpr int NEXP = 32, DE = 512, NMODW = 6 * D;
constexpr float EPS = 1e-6f;
constexpr float LAMBDA_INIT = 0.2f;
constexpr float LOG2E = 1.4426950408889634f;
constexpr float C2 = 0.125f * LOG2E;
constexpr int NT = 512;
constexpr int LISTCAP = 16384;
constexpr int RCH = 128;

#define LAS __attribute__((address_space(3)))
typedef unsigned short bf16_t;
typedef short bf16x8 __attribute__((ext_vector_type(8)));
typedef float f32x4 __attribute__((ext_vector_type(4)));
typedef float f32x16 __attribute__((ext_vector_type(16)));
typedef unsigned u32x4 __attribute__((ext_vector_type(4)));
typedef unsigned u32x2 __attribute__((ext_vector_type(2)));

__device__ __forceinline__ float siluf(float v) { return v / (1.0f + __expf(-v)); }
__device__ __forceinline__ float wave_sum(float v) {
#pragma unroll
    for (int o = 1; o < 64; o <<= 1) v += __shfl_xor(v, o);
    return v;
}
__device__ __forceinline__ unsigned f2bf(float f) { unsigned u = __builtin_bit_cast(unsigned, f); return (u + 0x7fffu + ((u >> 16) & 1u)) >> 16; }
__device__ __forceinline__ unsigned pk2(float lo, float hi) { return f2bf(lo) | (f2bf(hi) << 16); }
__device__ __forceinline__ float bf2f(bf16_t v) { return __builtin_bit_cast(float, (unsigned)v << 16); }
__device__ __forceinline__ float bflo(unsigned w) { return __builtin_bit_cast(float, w << 16); }
__device__ __forceinline__ float bfhi(unsigned w) { return __builtin_bit_cast(float, w & 0xffff0000u); }
__device__ __forceinline__ unsigned ld_cnt(const unsigned* p) { return __hip_atomic_load(p, __ATOMIC_RELAXED, __HIP_MEMORY_SCOPE_AGENT); }

typedef __attribute__((address_space(1))) unsigned gu32;
#define XB_TMO      128
#define XB_XCNT(j)  (256  + 64 * (j))
#define XB_XSUB(j)  (1280 + 64 * (j))
#define XB_XGEN(j)  (2304 + 64 * (j))
#define XB_TOP      3328
#define XB_TOPGEN   3392
#define XCD_BAR_WORDS 3456
#define XB_SPIN_CAP (1u << 18)

__device__ __forceinline__ unsigned xb_ld(unsigned* p)              { return __hip_atomic_load(p, __ATOMIC_RELAXED, __HIP_MEMORY_SCOPE_AGENT); }
__device__ __forceinline__ unsigned xb_add(unsigned* p, unsigned v) { return __hip_atomic_fetch_add(p, v, __ATOMIC_RELAXED, __HIP_MEMORY_SCOPE_AGENT); }
__device__ __forceinline__ unsigned xb_xcc_id() { return (unsigned)__builtin_amdgcn_s_getreg((3 << 11) | 20) & 0xFu; }
#define XB_SPIN(cond, bar) do { unsigned _sp = 0; while (cond) { __builtin_amdgcn_s_sleep(1); \
    if ((++_sp & 255u) == 0u) { if (xb_ld(&(bar)[XB_TMO])) break; if (_sp > XB_SPIN_CAP) { atomicAdd(&(bar)[XB_TMO], 1u); break; } } } } while (0)

struct XcdBarrier {
    unsigned* bar; unsigned x;
    volatile LAS unsigned* st;
};

__device__ __forceinline__ XcdBarrier xcd_barrier_post(unsigned* bar, volatile LAS unsigned* st) {
    XcdBarrier b; b.bar = bar; b.x = xb_xcc_id(); b.st = st;
    if (threadIdx.x == 0) (void)xb_add(&bar[XB_XCNT(b.x)], 1u);
    return b;
}
__device__ __forceinline__ void xcd_barrier_complete(unsigned* bar, unsigned x, unsigned& nloc, unsigned& nx) {
    const unsigned G = gridDim.x * gridDim.y * gridDim.z;
    unsigned sum, cnt, mine, sp = 0u;
    for (;;) {
        sum = 0u; cnt = 0u; mine = 0u;
#pragma unroll
        for (unsigned j = 0; j < 16; ++j) { const unsigned c = xb_ld(&bar[XB_XCNT(j)]); sum += c; cnt += (c > 0u) ? 1u : 0u; mine = (j == x) ? c : mine; }
        if (sum == G) break;
        __builtin_amdgcn_s_sleep(1);
        if ((++sp & 255u) == 0u) { if (xb_ld(&bar[XB_TMO])) break; if (sp > XB_SPIN_CAP) { atomicAdd(&bar[XB_TMO], 1u); break; } }
    }
    nloc = mine > 0u ? mine : 1u; nx = cnt > 0u ? cnt : 1u;
}

__device__ __forceinline__ void xcd_barrier(const XcdBarrier& b) {
    asm volatile("s_waitcnt vmcnt(0)" ::: "memory");
    __syncthreads();
    if (threadIdx.x == 0) {
        unsigned* bar = b.bar;
        __builtin_amdgcn_s_waitcnt(0);
        unsigned nloc = b.st[0], nx = b.st[1];
        if (nloc == 0u) { xcd_barrier_complete(bar, b.x, nloc, nx); b.st[0] = nloc; b.st[1] = nx; }
        const unsigned old = xb_add(&bar[XB_XSUB(b.x)], 1u);
        const unsigned gen = old / nloc;
        if (old + 1u == (gen + 1u) * nloc) {
            __builtin_amdgcn_fence(__ATOMIC_RELEASE, "agent");
            asm volatile("s_waitcnt vmcnt(0)" ::: "memory");
            const unsigned og = xb_add(&bar[XB_TOP], 1u);
            const unsigned tg = og / nx;
            if (og + 1u == (tg + 1u) * nx) xb_add(&bar[XB_TOPGEN], 1u);
            else XB_SPIN(xb_ld(&bar[XB_TOPGEN]) == tg, bar);
            __builtin_amdgcn_fence(__ATOMIC_ACQUIRE, "agent");
            xb_add(&bar[XB_XGEN(b.x)], 1u);
            asm volatile("s_waitcnt vmcnt(0)" ::: "memory");
        } else {
            XB_SPIN(xb_ld(&bar[XB_XGEN(b.x)]) == gen, bar);
            __builtin_amdgcn_fence(__ATOMIC_ACQUIRE, "agent");
            asm volatile("s_waitcnt vmcnt(0)" ::: "memory");
        }
    }
    __syncthreads();
}
namespace pg8 {
constexpr int BM = 256, BK = 64, HALF = 128, HTB = HALF * BK * 2  , STAGE_BYTES = 8 * HTB;

__host__ __device__ __forceinline__ int lds_byte(int r, int c) { const int st = (r >> 4) * 2 + (c >> 5), rr = r & 15, cc = c & 31, ob = rr * 64 + cc * 2; return st * 1024 + (ob ^ (((ob >> 9) & 1) << 5)); }
__host__ __device__ __forceinline__ void stage_rc(int b, int& R, int& C) { const int st = b / 1024, sb = b % 1024, swz = sb ^ (((sb >> 9) & 1) << 5); R = (st >> 1) * 16 + swz / 64; C = (st & 1) * 32 + (swz % 64) / 2; }
__host__ __device__ __forceinline__ int perm32(int rho) { const int n = rho >> 4, i = rho & 15; return 8 * (i >> 2) + 4 * n + (i & 3); }

struct Unit { const char* a; const char* b; const int* rows; int nvalid; int pm, pn, aux; };

__device__ __forceinline__ unsigned cvt_pk_bf16(float lo, float hi) { typedef float f32x2_t __attribute__((ext_vector_type(2))); typedef __bf16 bf16x2_t __attribute__((ext_vector_type(2))); f32x2_t v = {lo, hi}; bf16x2_t b = __builtin_convertvector(v, bf16x2_t); return __builtin_bit_cast(unsigned, b); }

template <class Epi, class Sched, bool ALIGN_EPI, bool GATHER>
__device__ __forceinline__ void gemm_phase(LAS unsigned char* lds, const int K, const Sched& S, const Epi& E) {
    const int tid = threadIdx.x, wid = __builtin_amdgcn_readfirstlane(tid >> 6), lane = tid & 63, wr = wid >> 2, wc = wid & 3, fr = lane & 15, fq = lane >> 4;
    const int nt = K / BK;
    int Rr[2], Cc[2]; unsigned voffB[2];
#pragma unroll
    for (int i = 0; i < 2; ++i) { int R, C; stage_rc(tid * 16 + i * 8192, R, C); const int Rb = Epi::PERM ? ((R & ~31) + perm32(R & 31)) : R;
        Rr[i] = R; Cc[i] = C; voffB[i] = (unsigned)(Rb * K + C) * 2u; }
    const size_t kstep = (size_t)(BK * 2);
    const size_t hstep = (size_t)HALF * K * 2;
    const unsigned ldsw = (unsigned)wid * 1024u;
    const int aoff = lds_byte(wr * 64 + fr, fq * 8), boff = lds_byte(wc * 32 + fr, fq * 8);
#define PG8_SA(b, h) (((b) * 2 + (h)) * HTB)
#define PG8_SB(b, h) ((4 + (b) * 2 + (h)) * HTB)
#define PG8_STAGE(bufoff, gbase, voff) do { _Pragma("unroll") for (int _i = 0; _i < 2; ++_i) \
        __builtin_amdgcn_global_load_lds((const unsigned*)((const char*)(gbase) + (voff)[_i]), (LAS unsigned*)(lds + (bufoff) + ldsw + _i * 8192), 16, 0, 0); } while (0)
#define PG8_LDA(dst, b, h) do { _Pragma("unroll") for (int m = 0; m < 4; ++m) _Pragma("unroll") for (int k = 0; k < 2; ++k) dst[m][k] = *(const LAS bf16x8*)(lds + PG8_SA(b, h) + aoff + m * 2048 + k * 1024); } while (0)
#define PG8_LDB(dst, b, h) do { _Pragma("unroll") for (int n = 0; n < 2; ++n) _Pragma("unroll") for (int k = 0; k < 2; ++k) dst[n][k] = *(const LAS bf16x8*)(lds + PG8_SB(b, h) + boff + n * 2048 + k * 1024); } while (0)
#define PG8_MMA(ai, bj, At, Bt) do { __builtin_amdgcn_s_setprio(1); _Pragma("unroll") for (int m = 0; m < 4; ++m) _Pragma("unroll") for (int n = 0; n < 2; ++n) _Pragma("unroll") for (int k = 0; k < 2; ++k) \
        acc[ai][bj][m][n] = __builtin_amdgcn_mfma_f32_16x16x32_bf16(Bt[n][k], At[m][k], acc[ai][bj][m][n], 0, 0, 0); __builtin_amdgcn_s_setprio(0); } while (0)
#define PG8_WAIT_V(n) asm volatile("s_waitcnt vmcnt(" #n ")" ::: "memory")
#define PG8_WAIT_L(n) asm volatile("s_waitcnt lgkmcnt(" #n ")" ::: "memory")
#define PG8_BAR __builtin_amdgcn_s_barrier()
#define PG8_SCHED __builtin_amdgcn_sched_barrier(0)
#define PG8_MKA(u, v0, v1) do { _Pragma("unroll") for (int _i = 0; _i < 2; ++_i) { \
        if (GATHER) { const int _l = (u).nvalid - 1; const int _r0 = Rr[_i] < _l ? Rr[_i] : _l, _r1 = (Rr[_i] + HALF) < _l ? (Rr[_i] + HALF) : _l; \
            (v0)[_i] = (unsigned)((u).rows[_r0] * K + Cc[_i]) * 2u; (v1)[_i] = (unsigned)((u).rows[_r1] * K + Cc[_i]) * 2u; } \
        else { (v0)[_i] = (unsigned)(Rr[_i] * K + Cc[_i]) * 2u; (v1)[_i] = (v0)[_i] + (unsigned)(HALF * K * 2); } } } while (0)
    Unit cur, nxt; int ui = 0;
    if (!S.next(0, cur)) return;
    f32x4 acc[2][2][4][2];
#pragma unroll
    for (int a = 0; a < 2; ++a)
#pragma unroll
        for (int b = 0; b < 2; ++b)
#pragma unroll
            for (int m = 0; m < 4; ++m)
#pragma unroll
                for (int n = 0; n < 2; ++n) acc[a][b][m][n] = (f32x4){0.f, 0.f, 0.f, 0.f};
    bf16x8 At[4][2], B0[2][2], B1[2][2];
    const char* cA = cur.a; const char* cB = cur.b;
    unsigned vA0[2], vA1[2], nA0[2], nA1[2];
    PG8_MKA(cur, vA0, vA1);
    PG8_STAGE(PG8_SB(0, 0), cB, voffB); PG8_STAGE(PG8_SB(0, 1), cB + hstep, voffB); PG8_STAGE(PG8_SA(0, 0), cA, vA0); PG8_STAGE(PG8_SA(0, 1), cA, vA1);
    if (wr == 1) PG8_BAR;
    PG8_WAIT_V(2); PG8_BAR;
    PG8_STAGE(PG8_SB(1, 0), cB + kstep, voffB); PG8_STAGE(PG8_SA(1, 0), cA + kstep, vA0); PG8_STAGE(PG8_SB(1, 1), cB + hstep + kstep, voffB);
    PG8_WAIT_V(6); PG8_BAR;
    for (;;) {
        const bool has_next = S.next(ui + 1, nxt);
        const char* nA = has_next ? nxt.a : cA; const char* nB = has_next ? nxt.b : cB;
        if (has_next) { PG8_MKA(nxt, nA0, nA1); } else { nA0[0] = vA0[0]; nA0[1] = vA0[1]; nA1[0] = vA1[0]; nA1[1] = vA1[1]; }
        for (int t = 0; t < nt; t += 2) {
            const bool last = (t == nt - 2);
            const char* a1 = cA + (size_t)(t + 1) * kstep;
            const char* a2 = last ? nA : cA + (size_t)(t + 2) * kstep; const char* b2 = last ? nB : cB + (size_t)(t + 2) * kstep;
            const char* a3 = a2 + kstep; const char* b3 = b2 + kstep;
            unsigned x0[2], x1[2];
            x0[0] = last ? nA0[0] : vA0[0]; x0[1] = last ? nA0[1] : vA0[1]; x1[0] = last ? nA1[0] : vA1[0]; x1[1] = last ? nA1[1] : vA1[1];
            PG8_LDB(B0, 0, 0); PG8_LDB(B1, 0, 1); PG8_SCHED; PG8_LDA(At, 0, 0); PG8_STAGE(PG8_SA(1, 1), a1, vA1);
            PG8_WAIT_V(8); PG8_WAIT_L(0); PG8_BAR; PG8_MMA(0, 0, At, B0); PG8_MMA(0, 1, At, B1); PG8_BAR; PG8_SCHED;
            PG8_LDA(At, 0, 1); PG8_STAGE(PG8_SB(0, 0), b2, voffB); PG8_STAGE(PG8_SB(0, 1), b2 + hstep, voffB); PG8_STAGE(PG8_SA(0, 0), a2, x0);
            PG8_WAIT_V(8); PG8_WAIT_L(0); PG8_BAR; PG8_MMA(1, 0, At, B0); PG8_MMA(1, 1, At, B1); PG8_BAR; PG8_SCHED;
            PG8_LDB(B0, 1, 0); PG8_LDB(B1, 1, 1); PG8_SCHED; PG8_LDA(At, 1, 0); PG8_STAGE(PG8_SA(0, 1), a2, x1);
            PG8_WAIT_V(8); PG8_WAIT_L(0); PG8_BAR; PG8_MMA(0, 0, At, B0); PG8_MMA(0, 1, At, B1); PG8_BAR; PG8_SCHED;
            PG8_LDA(At, 1, 1); PG8_STAGE(PG8_SB(1, 0), b3, voffB); PG8_STAGE(PG8_SB(1, 1), b3 + hstep, voffB); PG8_STAGE(PG8_SA(1, 0), a3, x0);
            PG8_WAIT_V(8); PG8_WAIT_L(0); PG8_BAR; PG8_MMA(1, 0, At, B0); PG8_MMA(1, 1, At, B1); PG8_BAR; PG8_SCHED;
        }
        if constexpr (ALIGN_EPI) { if (wr == 0) PG8_BAR; }
        E(acc, cur, wr, wc, fr, fq);
        if (!has_next) break;
#pragma unroll
        for (int a = 0; a < 2; ++a)
#pragma unroll
            for (int b = 0; b < 2; ++b)
#pragma unroll
                for (int m = 0; m < 4; ++m)
#pragma unroll
                    for (int n = 0; n < 2; ++n) acc[a][b][m][n] = (f32x4){0.f, 0.f, 0.f, 0.f};
        cur = nxt; cA = nA; cB = nB; ++ui;
        vA0[0] = nA0[0]; vA0[1] = nA0[1]; vA1[0] = nA1[0]; vA1[1] = nA1[1];
        if constexpr (ALIGN_EPI) { if (wr == 1) PG8_BAR; }
    }
    PG8_WAIT_V(0);
    if constexpr (!ALIGN_EPI) { if (wr == 0) PG8_BAR; }
    PG8_BAR;
#undef PG8_SA
#undef PG8_SB
#undef PG8_STAGE
#undef PG8_LDA
#undef PG8_LDB
#undef PG8_MMA
#undef PG8_WAIT_V
#undef PG8_WAIT_L
#undef PG8_BAR
#undef PG8_SCHED
#undef PG8_MKA
}
}

struct StaticSched {
    const char* A; const char* Bt; int K, nM, nN, nwg, G, c;
    __device__ __forceinline__ void init(const void* A_, const void* Bt_, int Mrows, int N, int K_, int G_, int c_) { A = (const char*)A_; Bt = (const char*)Bt_; K = K_; nM = Mrows / 256; nN = N / 256; nwg = nM * nN; G = G_; c = c_; }
    __device__ __forceinline__ bool next(int i, pg8::Unit& u) const {
        const long L = (long)i * G + c; if (L >= nwg) return false;
        int wgid = (int)L; { const int q = nwg / 8, r = nwg % 8, xcd = wgid % 8, off = wgid / 8; wgid = (xcd < r ? xcd * (q + 1) : r * (q + 1) + (xcd - r) * q) + off; }
        const int nig = 8 * nN, gid = wgid / nig, fm = gid * 8, gsz = (nM - fm) < 8 ? (nM - fm) : 8;
        u.pm = fm + ((wgid % nig) % gsz); u.pn = (wgid % nig) / gsz; u.aux = 0; u.rows = nullptr; u.nvalid = 256;
        u.a = A + (size_t)u.pm * 256 * K * 2; u.b = Bt + (size_t)u.pn * 256 * K * 2; return true;
    }
};

struct EpiProj {
    static constexpr bool PERM = true;
    bf16_t* proj; const float* rc; const float* rs;
    __device__ __forceinline__ void operator()(const f32x4 (&acc)[2][2][4][2], const pg8::Unit& u, int wr, int wc, int fr, int fq) const {
        const int row0 = u.pm * 256 + wr * 64 + fr, col0 = u.pn * 256 + wc * 32 + 8 * fq;
        const int kind = (u.pn < 2) ? 1 : (u.pn < 4) ? 2 : (u.pn == 8 || u.pn == 9) ? 3 : 0;
#pragma unroll
        for (int ai = 0; ai < 2; ++ai)
#pragma unroll
            for (int m = 0; m < 4; ++m) {
                const int row = row0 + ai * 128 + m * 16; const int pos = row & (SEQ - 1);
                bf16_t* rowp = proj + (size_t)row * INW + col0;
#pragma unroll
                for (int bj = 0; bj < 2; ++bj) {
                    f32x4 v0 = acc[ai][bj][m][0], v1 = acc[ai][bj][m][1];
                    if (kind == 1 || kind == 2) {
                        const int c = col0 + bj * 128; const int d0 = (c & 63) >> 1; const int h = (c & 511) >> 6;
                        const f32x4 cs = *(const f32x4*)(rc + pos * 32 + d0), sn = *(const f32x4*)(rs + pos * 32 + d0);
                        const float lg2 = log2f(1.0f - exp2f(-5.0f - (float)h));
                        const float il = (float)(pos & (RCH - 1));
                        const float sc = (kind == 1) ? exp2f(lg2 * il) : 0.125f * exp2f(-lg2 * il);
                        f32x4 o0, o1;
                        o0[0] = (v0[0] * cs[0] - v0[1] * sn[0]) * sc; o0[1] = (v0[1] * cs[0] + v0[0] * sn[0]) * sc;
                        o0[2] = (v0[2] * cs[1] - v0[3] * sn[1]) * sc; o0[3] = (v0[3] * cs[1] + v0[2] * sn[1]) * sc;
                        o1[0] = (v1[0] * cs[2] - v1[1] * sn[2]) * sc; o1[1] = (v1[1] * cs[2] + v1[0] * sn[2]) * sc;
                        o1[2] = (v1[2] * cs[3] - v1[3] * sn[3]) * sc; o1[3] = (v1[3] * cs[3] + v1[2] * sn[3]) * sc;
                        v0 = o0; v1 = o1;
                    } else if (kind == 3) { v0 = v0 * C2; v1 = v1 * C2; }
                    u32x4 w; w.x = pg8::cvt_pk_bf16(v0[0], v0[1]); w.y = pg8::cvt_pk_bf16(v0[2], v0[3]); w.z = pg8::cvt_pk_bf16(v1[0], v1[1]); w.w = pg8::cvt_pk_bf16(v1[2], v1[3]);
                    *(u32x4*)(rowp + bj * 128) = w;
                }
            }
    }
};

template <class RowMap>
__device__ __forceinline__ void transpose64(const float* src_lane, size_t ld, bf16_t* dst_k0, int dstK, RowMap rowmap, LAS float* scr, int lane) {
#pragma unroll 16
    for (int kk = 0; kk < 64; ++kk) scr[kk * 65 + lane] = src_lane[(size_t)kk * ld];
    asm volatile("s_waitcnt lgkmcnt(0)" ::: "memory");
    const int c = lane & 7;
#pragma unroll
    for (int jj = 0; jj < 8; ++jj) {
        const int slot = (lane >> 3) + 8 * jj; const LAS float* s = scr + (8 * c) * 65 + slot;
        u32x4 o; o.x = pk2(s[0 * 65], s[1 * 65]); o.y = pk2(s[2 * 65], s[3 * 65]); o.z = pk2(s[4 * 65], s[5 * 65]); o.w = pk2(s[6 * 65], s[7 * 65]);
        *(u32x4*)(dst_k0 + (size_t)rowmap(slot) * dstK + 8 * c) = o;
    }
    asm volatile("s_waitcnt lgkmcnt(0)" ::: "memory");
}

struct EpiRes {
    static constexpr bool PERM = false;
    const float* x; const float* mod; float* x1;
    __device__ __forceinline__ void operator()(const f32x4 (&acc)[2][2][4][2], const pg8::Unit& u, int wr, int wc, int fr, int fq) const {
        const int row0 = u.pm * 256 + wr * 64 + fr, col0 = u.pn * 256 + wc * 32 + 4 * fq;
        const int b = row0 >> 12;
        f32x4 gv[2][2];
#pragma unroll
        for (int bj = 0; bj < 2; ++bj)
#pragma unroll
            for (int n = 0; n < 2; ++n) gv[bj][n] = *(const f32x4*)(mod + b * NMODW + 2 * D + col0 + bj * 128 + n * 16);
#pragma unroll
        for (int ai = 0; ai < 2; ++ai)
#pragma unroll
            for (int m = 0; m < 4; ++m) {
                const size_t off = (size_t)(row0 + ai * 128 + m * 16) * D + col0;
#pragma unroll
                for (int bj = 0; bj < 2; ++bj)
#pragma unroll
                    for (int n = 0; n < 2; ++n) {
                        const f32x4 xv = *(const f32x4*)(x + off + bj * 128 + n * 16);
                        *(f32x4*)(x1 + off + bj * 128 + n * 16) = xv + gv[bj][n] * acc[ai][bj][m][n];
                    }
                if (m & 1) asm volatile("" ::: "memory");
            }
    }
};

struct EpiHid {
    static constexpr bool PERM = true;
    bf16_t* hid; const int* list; const float* listw;
    __device__ __forceinline__ void operator()(const f32x4 (&acc)[2][2][4][2], const pg8::Unit& u, int wr, int wc, int fr, int fq) const {
        const int rl0 = wr * 64 + fr; const int f0 = u.pn * 128 + wc * 16 + fq * 4;
        const float* lw = listw + (u.rows - list);
#pragma unroll
        for (int ai = 0; ai < 2; ++ai)
#pragma unroll
            for (int m = 0; m < 4; ++m) {
                const int rl = rl0 + ai * 128 + m * 16;
                const float w = (rl < u.nvalid) ? lw[rl] : 0.f;
                bf16_t* rowp = hid + (size_t)(u.pm + rl) * DE + f0;
#pragma unroll
                for (int bj = 0; bj < 2; ++bj) {
                    const f32x4 g = acc[ai][bj][m][0], up = acc[ai][bj][m][1];
                    u32x2 o; o.x = pg8::cvt_pk_bf16(siluf(g[0]) * up[0] * w, siluf(g[1]) * up[1] * w); o.y = pg8::cvt_pk_bf16(siluf(g[2]) * up[2] * w, siluf(g[3]) * up[3] * w);
                    *(u32x2*)(rowp + bj * 64) = o;
                }
            }
    }
};

struct EpiY {
    static constexpr bool PERM = true;
    bf16_t* y;
    __device__ __forceinline__ void operator()(const f32x4 (&acc)[2][2][4][2], const pg8::Unit& u, int wr, int wc, int fr, int fq) const {
        const int rl0 = wr * 64 + fr; const int col0 = u.pn * 256 + wc * 32 + 8 * fq;
#pragma unroll
        for (int ai = 0; ai < 2; ++ai)
#pragma unroll
            for (int m = 0; m < 4; ++m) {
                bf16_t* rowp = y + (size_t)(u.pm + rl0 + ai * 128 + m * 16) * D + col0;
#pragma unroll
                for (int bj = 0; bj < 2; ++bj) {
                    const f32x4 v0 = acc[ai][bj][m][0], v1 = acc[ai][bj][m][1];
                    u32x4 w; w.x = pg8::cvt_pk_bf16(v0[0], v0[1]); w.y = pg8::cvt_pk_bf16(v0[2], v0[3]); w.z = pg8::cvt_pk_bf16(v1[0], v1[1]); w.w = pg8::cvt_pk_bf16(v1[2], v1[3]);
                    *(u32x4*)(rowp + bj * 128) = w;
                }
            }
    }
};

struct MoeSched {
    const LAS int* tab; const char* A; const char* Bt; const int* list; int K, bexp  , gather, G, c;
    __device__ __forceinline__ bool next(int i, pg8::Unit& u) const {
        const int L = i * G + c; if (L >= tab[96]) return false;
        int e = 0;
#pragma unroll 1
        for (int q = 1; q < NEXP; ++q) if (tab[64 + q] <= L) e = q;
        const int li = L - tab[64 + e], mt = li >> 2, pn = li & 3, cnt = tab[e], off = tab[32 + e];
        u.pm = off + mt * 256; u.pn = pn; u.aux = e; u.nvalid = cnt - mt * 256; u.rows = list + e * LISTCAP + mt * 256;
        u.a = gather ? A : A + (size_t)u.pm * K * 2; u.b = Bt + (size_t)e * bexp + (size_t)pn * 256 * K * 2; return true;
    }
};
__device__ __forceinline__ void moe_table(const unsigned* cnt, LAS int* tab) {
    if (threadIdx.x == 0) { int off = 0, ub = 0;
        for (int e = 0; e < NEXP; ++e) { const int c = (int)ld_cnt(cnt + e); tab[e] = c; tab[32 + e] = off; tab[64 + e] = ub; off += ((c + 255) >> 8) << 8; ub += ((c + 255) >> 8) * 4; }
        tab[96] = ub; }
    __syncthreads();
}

constexpr size_t MiB = 1u << 20;
constexpr size_t WS_MOD = 0;
constexpr size_t WS_ROPE_C = 128 * 1024;
constexpr size_t WS_ROPE_S = WS_ROPE_C + 512 * 1024;
constexpr size_t WS_CNT = WS_ROPE_S + 512 * 1024;
constexpr size_t WS_TOKSLOT = 2 * MiB;
constexpr size_t WS_LIST = 3 * MiB;
constexpr size_t WS_LISTW = 5 * MiB;
constexpr size_t WS_BAR = 7 * MiB;
constexpr size_t WS_WIN = 8 * MiB;
constexpr size_t WS_WO = 15 * MiB;
constexpr size_t WS_WGU = 17 * MiB;
constexpr size_t WS_WD = 81 * MiB;
constexpr size_t WS_ACT = 113 * MiB;
constexpr size_t WS_PROJ = 145 * MiB;
constexpr size_t WS_HID = 145 * MiB;
constexpr size_t WS_Y = 185 * MiB;
constexpr size_t WS_END = 265 * MiB;
static_assert(WS_PROJ + (size_t)M * INW * 2 <= WS_END, "ws map");

constexpr int LDS_BYTES = 147456;
constexpr int RING_BYTES = 131072;
constexpr int TAB_OFF = 140 * 1024;
constexpr int MISC_OFF = 142 * 1024;

struct Params {
    const float *x, *c, *ada_w, *ada_b, *g1, *g2, *w_in, *w_out, *ret_gn, *lq1, *lk1, *lq2, *lk2, *subln;
    const float *w_group, *b_group, *w_expert, *b_expert, *w_gate, *w_up, *w_down, *final_gain;
    float* out; unsigned char* ws;
    int ph_lo, ph_hi;
};

__device__ __forceinline__ void ph_p0(const Params& p, float* sm, LAS unsigned char* lds) {
    const int tid = threadIdx.x;
    float* mod = (float*)(p.ws + WS_MOD);
    float* csil = sm;
    float* red = sm + 4096;
    for (int i = tid; i < 4096; i += NT) csil[i] = siluf(p.c[i]);
    __syncthreads();
    const int col = tid & 31, ks = tid >> 5;
    for (int it = blockIdx.x; it < NMODW / 32; it += gridDim.x) {
        const int n0 = it * 32;
        float a0 = 0.f, a1 = 0.f, a2 = 0.f, a3 = 0.f;
        for (int k = ks * 64; k < ks * 64 + 64; ++k) {
            const float w = p.ada_w[(size_t)k * NMODW + n0 + col];
            a0 += csil[k] * w; a1 += csil[1024 + k] * w; a2 += csil[2048 + k] * w; a3 += csil[3072 + k] * w;
        }
        red[(ks * 4 + 0) * 32 + col] = a0; red[(ks * 4 + 1) * 32 + col] = a1; red[(ks * 4 + 2) * 32 + col] = a2; red[(ks * 4 + 3) * 32 + col] = a3;
        __syncthreads();
        if (tid < 128) {
            const int b = tid >> 5, cc = tid & 31;
            float s = p.ada_b[n0 + cc];
            for (int q = 0; q < 16; ++q) s += red[(q * 4 + b) * 32 + cc];
            mod[b * NMODW + n0 + cc] = s;
        }
        __syncthreads();
    }
    float* rc = (float*)(p.ws + WS_ROPE_C); float* rs = (float*)(p.ws + WS_ROPE_S);
    for (int i = blockIdx.x * NT + tid; i < SEQ * 32; i += gridDim.x * NT) {
        const int pos = i >> 5, d = i & 31;
        const float inv = 1.0f / powf(10000.0f, (float)d / 32.0f);
        const float ang = (float)pos * inv;
        const double tq = (double)ang * 0.15915494309189535;
        const float fr = (float)(tq - rint(tq));
        rc[i] = __builtin_amdgcn_cosf(fr); rs[i] = __builtin_amdgcn_sinf(fr);
    }
    if (blockIdx.x == 0 && tid < 64) ((unsigned*)(p.ws + WS_CNT))[tid] = 0u;
    __syncthreads();
    const int lane = tid & 63, wave = tid >> 6;
    LAS float* scr = (LAS float*)(lds + wave * 16640);
    bf16_t* WinT = (bf16_t*)(p.ws + WS_WIN); bf16_t* WoT = (bf16_t*)(p.ws + WS_WO); bf16_t* WguT = (bf16_t*)(p.ws + WS_WGU); bf16_t* WdT = (bf16_t*)(p.ws + WS_WD);
    constexpr int I_IN = 16 * 56, I_O = 16 * 16, I_GU = NEXP * 256, I_D = NEXP * 128;
    for (int it = blockIdx.x * 8 + wave; it < I_IN + I_O + I_GU + I_D; it += gridDim.x * 8) {
        int r = it;
        if (r < I_IN) {
            const int kb = r / 56, nb = r % 56, k0 = kb * 64, n0 = nb * 64;
            transpose64(p.w_in + (size_t)k0 * INW + n0 + lane, INW, WinT + k0, D,
                        [=](int slot) { return (n0 < 1024) ? n0 + 2 * (slot & 31) + (slot >> 5) : n0 + slot; }, scr, lane);
            continue;
        }
        r -= I_IN;
        if (r < I_O) {
            const int kb = r >> 4, nb = r & 15, k0 = kb * 64, n0 = nb * 64;
            transpose64(p.w_out + (size_t)k0 * D + n0 + lane, D, WoT + k0, D, [=](int slot) { return n0 + slot; }, scr, lane);
            continue;
        }
        r -= I_O;
        if (r < I_GU) {
            const int e = r >> 8, kb = (r >> 4) & 15, fb = r & 15, k0 = kb * 64, f0 = fb * 32;
            const float* src = ((lane < 32) ? p.w_gate : p.w_up) + (size_t)e * D * DE + (size_t)k0 * DE + f0 + (lane & 31);
            transpose64(src, DE, WguT + (size_t)e * D * D + k0, D,
                        [=](int slot) { const int f = f0 + (slot & 31); return 8 * (f >> 2) + (f & 3) + 4 * (slot >> 5); }, scr, lane);
            continue;
        }
        r -= I_GU;
        {
            const int e = r >> 7, kb = (r >> 4) & 7, nb = r & 15, k0 = kb * 64, n0 = nb * 64;
            transpose64(p.w_down + (size_t)e * DE * D + (size_t)k0 * D + n0 + lane, D, WdT + (size_t)e * D * DE + k0, DE, [=](int slot) { return n0 + slot; }, scr, lane);
        }
    }
}

__device__ __forceinline__ void ph_p1(const Params& p) {
    const float* mod = (const float*)(p.ws + WS_MOD); bf16_t* h1 = (bf16_t*)(p.ws + WS_ACT);
    const int lane = threadIdx.x & 63, wave = threadIdx.x >> 6;
    for (int row = blockIdx.x * 8 + wave; row < M; row += gridDim.x * 8) {
        const int b = row >> 12;
        const float4* xr = (const float4*)(p.x + (size_t)row * D);
        float4 v[4]; float ss = 0.f;
#pragma unroll
        for (int j = 0; j < 4; ++j) { v[j] = xr[lane + 64 * j]; ss += v[j].x * v[j].x + v[j].y * v[j].y + v[j].z * v[j].z + v[j].w * v[j].w; }
        ss = wave_sum(ss);
        const float rstd = 1.0f / sqrtf(ss * (1.0f / D) + EPS);
#pragma unroll
        for (int j = 0; j < 4; ++j) {
            const int c0 = 4 * (lane + 64 * j);
            const float4 g = *(const float4*)(p.g1 + c0);
            const float4 sh = *(const float4*)(mod + b * NMODW + 0 * D + c0);
            const float4 sc = *(const float4*)(mod + b * NMODW + 1 * D + c0);
            const float o0 = v[j].x * rstd * g.x * (1.0f + sc.x) + sh.x, o1 = v[j].y * rstd * g.y * (1.0f + sc.y) + sh.y;
            const float o2 = v[j].z * rstd * g.z * (1.0f + sc.z) + sh.z, o3 = v[j].w * rstd * g.w * (1.0f + sc.w) + sh.w;
            u32x2 w; w.x = pk2(o0, o1); w.y = pk2(o2, o3);
            *(u32x2*)(h1 + (size_t)row * D + c0) = w;
        }
    }
}

__device__ __forceinline__ void ph_p2(const Params& p, LAS unsigned char* lds) {
    StaticSched S; S.init(p.ws + WS_ACT, p.ws + WS_WIN, M, INW, D, (int)gridDim.x, (int)blockIdx.x);
    EpiProj E{(bf16_t*)(p.ws + WS_PROJ), (const float*)(p.ws + WS_ROPE_C), (const float*)(p.ws + WS_ROPE_S)};
    pg8::gemm_phase<EpiProj, StaticSched, true, false>(lds, D, S, E);
}

__device__ __forceinline__ void ph_p4(const Params& p, LAS unsigned char* lds) {
    StaticSched S; S.init(p.ws + WS_ACT, p.ws + WS_WO, M, D, D, (int)gridDim.x, (int)blockIdx.x);
    EpiRes E{p.x, (const float*)(p.ws + WS_MOD), p.out};
    pg8::gemm_phase<EpiRes, StaticSched, true, false>(lds, D, S, E);
}

__device__ __forceinline__ void ph_p5(const Params& p, float* sm) {
    const float* x1 = p.out; bf16_t* h2 = (bf16_t*)(p.ws + WS_ACT);
    const float* mod = (const float*)(p.ws + WS_MOD);
    unsigned* cnt = (unsigned*)(p.ws + WS_CNT); unsigned* tokslot = (unsigned*)(p.ws + WS_TOKSLOT);
    int* list = (int*)(p.ws + WS_LIST); float* listw = (float*)(p.ws + WS_LISTW);
    const int tid = threadIdx.x, lane = tid & 63, wave = tid >> 6;
    float* H = sm;
    float* PART = sm + 16384;
    float* LOG = PART + 8 * 16 * 36;
    const int eo = lane & 31, half = lane >> 5, og = lane & 3, ks = lane >> 2;
    float we[64], wg8[8];
#pragma unroll
    for (int i = 0; i < 64; ++i) we[i] = p.w_expert[(size_t)(128 * wave + 64 * half + i) * 32 + eo];
#pragma unroll
    for (int i = 0; i < 8; ++i) wg8[i] = p.w_group[(size_t)(128 * wave + 8 * ks + i) * 4 + og];
    for (int bt = blockIdx.x; bt < M / 16; bt += gridDim.x) {
        const int row0 = bt * 16;
        __syncthreads();
#pragma unroll 1
        for (int rr = 0; rr < 2; ++rr) {
            const int rl = 2 * wave + rr, row = row0 + rl, b = row >> 12;
            const float4* xr = (const float4*)(x1 + (size_t)row * D);
            float4 v[4]; float ss = 0.f;
#pragma unroll
            for (int j = 0; j < 4; ++j) { v[j] = xr[lane + 64 * j]; ss += v[j].x * v[j].x + v[j].y * v[j].y + v[j].z * v[j].z + v[j].w * v[j].w; }
            ss = wave_sum(ss);
            const float rstd = 1.0f / sqrtf(ss * (1.0f / D) + EPS);
#pragma unroll
            for (int j = 0; j < 4; ++j) {
                const int c0 = 4 * (lane + 64 * j);
                const float4 g = *(const float4*)(p.g2 + c0);
                const float4 sh = *(const float4*)(mod + b * NMODW + 3 * D + c0);
                const float4 sc = *(const float4*)(mod + b * NMODW + 4 * D + c0);
                const float h0 = v[j].x * rstd * g.x * (1.0f + sc.x) + sh.x, h1 = v[j].y * rstd * g.y * (1.0f + sc.y) + sh.y;
                const float h2v = v[j].z * rstd * g.z * (1.0f + sc.z) + sh.z, h3 = v[j].w * rstd * g.w * (1.0f + sc.w) + sh.w;
                H[(c0 + 0) * 16 + rl] = h0; H[(c0 + 1) * 16 + rl] = h1; H[(c0 + 2) * 16 + rl] = h2v; H[(c0 + 3) * 16 + rl] = h3;
                u32x2 w; w.x = pk2(h0, h1); w.y = pk2(h2v, h3);
                *(u32x2*)(h2 + (size_t)row * D + c0) = w;
            }
        }
        __syncthreads();
        float acc[16], accg[16];
#pragma unroll
        for (int r = 0; r < 16; ++r) { acc[r] = 0.f; accg[r] = 0.f; }
        {
            const float* Hk = H + (size_t)(128 * wave + 64 * half) * 16;
#pragma unroll
            for (int i = 0; i < 64; ++i) {
                const float4 ha = *(const float4*)(Hk + i * 16), hb = *(const float4*)(Hk + i * 16 + 4), hc = *(const float4*)(Hk + i * 16 + 8), hd = *(const float4*)(Hk + i * 16 + 12);
                const float wv = we[i];
                acc[0] += wv * ha.x; acc[1] += wv * ha.y; acc[2] += wv * ha.z; acc[3] += wv * ha.w;
                acc[4] += wv * hb.x; acc[5] += wv * hb.y; acc[6] += wv * hb.z; acc[7] += wv * hb.w;
                acc[8] += wv * hc.x; acc[9] += wv * hc.y; acc[10] += wv * hc.z; acc[11] += wv * hc.w;
                acc[12] += wv * hd.x; acc[13] += wv * hd.y; acc[14] += wv * hd.z; acc[15] += wv * hd.w;
            }
            const float* Hg = H + (size_t)(128 * wave + 8 * ks) * 16;
#pragma unroll
            for (int i = 0; i < 8; ++i) {
                const float4 ha = *(const float4*)(Hg + i * 16), hb = *(const float4*)(Hg + i * 16 + 4), hc = *(const float4*)(Hg + i * 16 + 8), hd = *(const float4*)(Hg + i * 16 + 12);
                const float wv = wg8[i];
                accg[0] += wv * ha.x; accg[1] += wv * ha.y; accg[2] += wv * ha.z; accg[3] += wv * ha.w;
                accg[4] += wv * hb.x; accg[5] += wv * hb.y; accg[6] += wv * hb.z; accg[7] += wv * hb.w;
                accg[8] += wv * hc.x; accg[9] += wv * hc.y; accg[10] += wv * hc.z; accg[11] += wv * hc.w;
                accg[12] += wv * hd.x; accg[13] += wv * hd.y; accg[14] += wv * hd.z; accg[15] += wv * hd.w;
            }
        }
#pragma unroll
        for (int r = 0; r < 16; ++r) {
            acc[r] += __shfl_xor(acc[r], 32);
            float g = accg[r]; g += __shfl_xor(g, 4); g += __shfl_xor(g, 8); g += __shfl_xor(g, 16); g += __shfl_xor(g, 32); accg[r] = g;
        }
        if (lane < 32) {
#pragma unroll
            for (int r = 0; r < 16; ++r) PART[(wave * 16 + r) * 36 + 4 + eo] = acc[r];
        }
        if (lane < 4) {
#pragma unroll
            for (int r = 0; r < 16; ++r) PART[(wave * 16 + r) * 36 + og] = accg[r];
        }
        __syncthreads();
        for (int idx = tid; idx < 16 * 36; idx += NT) {
            float s = 0.f;
#pragma unroll
            for (int w = 0; w < 8; ++w) s += PART[w * 16 * 36 + idx];
            LOG[idx] = s;
        }
        __syncthreads();
        if (tid < 16) {
            const int row = row0 + tid;
            float lg[36];
#pragma unroll
            for (int q = 0; q < 36; ++q) lg[q] = LOG[tid * 36 + q];
            float gl[4]; int gi = 0;
#pragma unroll
            for (int q = 0; q < 4; ++q) gl[q] = lg[q] + p.b_group[q];
            float gmax = gl[0];
#pragma unroll
            for (int q = 1; q < 4; ++q) if (gl[q] > gmax) { gmax = gl[q]; gi = q; }
            float den = 0.f;
#pragma unroll
            for (int q = 0; q < 4; ++q) den += expf(gl[q] - gmax);
            const float gw = 1.0f / den;
            float el[8];
#pragma unroll
            for (int q = 0; q < 8; ++q) {
                float vsel = lg[4 + q];
                if (gi == 1) vsel = lg[4 + 8 + q]; else if (gi == 2) vsel = lg[4 + 16 + q]; else if (gi == 3) vsel = lg[4 + 24 + q];
                el[q] = vsel + p.b_expert[gi * 8 + q];
            }
            int i1 = 0; float v1 = el[0];
#pragma unroll
            for (int q = 1; q < 8; ++q) if (el[q] > v1) { v1 = el[q]; i1 = q; }
            int i2 = -1; float v2 = -INFINITY;
#pragma unroll
            for (int q = 0; q < 8; ++q) if (q != i1 && el[q] > v2) { v2 = el[q]; i2 = q; }
            if (i2 < 0) { i2 = (i1 == 0) ? 1 : 0; v2 = v1; }
            const float e2 = expf(v2 - v1);
            const float w1 = gw / (1.0f + e2), w2 = gw * e2 / (1.0f + e2);
            const int ea = gi * 8 + i1, eb = gi * 8 + i2;
            const unsigned pa = atomicAdd(&cnt[ea], 1u), pb = atomicAdd(&cnt[eb], 1u);
            list[ea * LISTCAP + pa] = row; listw[ea * LISTCAP + pa] = w1;
            list[eb * LISTCAP + pb] = row; listw[eb * LISTCAP + pb] = w2;
            tokslot[row * 2 + 0] = ((unsigned)ea << 16) | pa; tokslot[row * 2 + 1] = ((unsigned)eb << 16) | pb;
        }
    }
}

__device__ __forceinline__ void ph_p6(const Params& p, LAS unsigned char* lds) {
    LAS int* tab = (LAS int*)(lds + TAB_OFF);
    moe_table((const unsigned*)(p.ws + WS_CNT), tab);
    const int G = (int)gridDim.x, bx = (int)blockIdx.x, vc = (G % 8 == 0) ? (bx % 8) * (G / 8) + bx / 8 : bx;
    MoeSched S{tab, (const char*)(p.ws + WS_ACT), (const char*)(p.ws + WS_WGU), (const int*)(p.ws + WS_LIST), D, D * D * 2, 1, G, vc};
    EpiHid E{(bf16_t*)(p.ws + WS_HID), (const int*)(p.ws + WS_LIST), (const float*)(p.ws + WS_LISTW)};
    pg8::gemm_phase<EpiHid, MoeSched, true, true>(lds, D, S, E);
}

__device__ __forceinline__ void ph_p7(const Params& p, LAS unsigned char* lds) {
    LAS int* tab = (LAS int*)(lds + TAB_OFF);
    moe_table((const unsigned*)(p.ws + WS_CNT), tab);
    const int G = (int)gridDim.x, bx = (int)blockIdx.x, vc = (G % 8 == 0) ? (bx % 8) * (G / 8) + bx / 8 : bx;
    MoeSched S{tab, (const char*)(p.ws + WS_HID), (const char*)(p.ws + WS_WD), (const int*)(p.ws + WS_LIST), DE, D * DE * 2, 0, G, vc};
    EpiY E{(bf16_t*)(p.ws + WS_Y)};
    pg8::gemm_phase<EpiY, MoeSched, true, false>(lds, DE, S, E);
}

__device__ __forceinline__ void ph_p8(const Params& p, LAS unsigned char* lds) {
    LAS int* tab = (LAS int*)(lds + TAB_OFF);
    moe_table((const unsigned*)(p.ws + WS_CNT), tab);
    const float* mod = (const float*)(p.ws + WS_MOD); const bf16_t* y = (const bf16_t*)(p.ws + WS_Y); const unsigned* tokslot = (const unsigned*)(p.ws + WS_TOKSLOT);
    const int lane = threadIdx.x & 63, wave = threadIdx.x >> 6;
    for (int row = blockIdx.x * 8 + wave; row < M; row += gridDim.x * 8) {
        const int b = row >> 12;
        const unsigned s0 = tokslot[row * 2], s1 = tokslot[row * 2 + 1];
        const size_t r0 = (size_t)(tab[32 + (s0 >> 16)] + (int)(s0 & 0xffffu)), r1 = (size_t)(tab[32 + (s1 >> 16)] + (int)(s1 & 0xffffu));
        float4 v[4]; float ss = 0.f;
#pragma unroll
        for (int j = 0; j < 4; ++j) {
            const int c0 = 4 * (lane + 64 * j);
            const float4 a = *(const float4*)(p.out + (size_t)row * D + c0), g = *(const float4*)(mod + b * NMODW + 5 * D + c0);
            const u32x2 ya = *(const u32x2*)(y + r0 * D + c0), yb = *(const u32x2*)(y + r1 * D + c0);
            v[j].x = a.x + g.x * (bflo(ya.x) + bflo(yb.x)); v[j].y = a.y + g.y * (bfhi(ya.x) + bfhi(yb.x));
            v[j].z = a.z + g.z * (bflo(ya.y) + bflo(yb.y)); v[j].w = a.w + g.w * (bfhi(ya.y) + bfhi(yb.y));
            ss += v[j].x * v[j].x + v[j].y * v[j].y + v[j].z * v[j].z + v[j].w * v[j].w;
        }
        ss = wave_sum(ss);
        const float rstd = 1.0f / sqrtf(ss * (1.0f / D) + EPS);
#pragma unroll
        for (int j = 0; j < 4; ++j) {
            const int c0 = 4 * (lane + 64 * j);
            const float4 g = *(const float4*)(p.final_gain + c0);
            *(float4*)(p.out + (size_t)row * D + c0) = make_float4(v[j].x * rstd * g.x, v[j].y * rstd * g.y, v[j].z * rstd * g.z, v[j].w * rstd * g.w);
        }
    }
}

namespace ret {
typedef short v4i16_t __attribute__((ext_vector_type(4)));
constexpr int NPART = 8, CP = 32 / NPART;
constexpr int TQ = 16384, BUFB = 3 * TQ;
constexpr int Y_OFF = 2 * BUFB, YLD = 68;
constexpr int LDS_NEED = Y_OFF + 128 * YLD * 4;
__device__ __forceinline__ int crow(int r, int hi) { return (r & 3) + 8 * (r >> 2) + 4 * hi; }
__device__ __forceinline__ unsigned cvtpk(float lo, float hi) { typedef float f32x2_t __attribute__((ext_vector_type(2))); typedef __bf16 bf16x2_t __attribute__((ext_vector_type(2))); f32x2_t v = {lo, hi}; bf16x2_t b = __builtin_convertvector(v, bf16x2_t); return __builtin_bit_cast(unsigned, b); }
#define RT_TR(p) __builtin_amdgcn_ds_read_tr16_b64_v4i16((LAS v4i16_t*)(p))

__device__ __forceinline__ void unit(const bf16_t* proj, bf16_t* mix, const float* gn, int b, int h, int part, LAS unsigned char* lds) {
    const int tid = threadIdx.x, lane = tid & 63, r32 = lane & 31, hi = lane >> 5;
    const int wid = __builtin_amdgcn_readfirstlane(tid >> 6), a = wid & 3, dblk = wid >> 2;
    const size_t tb = (size_t)b * SEQ;
    const float lg2 = log2f(1.0f - exp2f(-5.0f - (float)h));
    const float gC = exp2f((float)RCH * lg2);
    const int n_pre = part * CP, total = n_pre + CP;
    const bf16_t* qsrc = proj + (tb + lane) * INW + OFF_RQ + h * 64 + wid * 8;
    const bf16_t* ksrc = proj + (tb + lane) * INW + OFF_RK + h * 64 + wid * 8;
    const bf16_t* vsrc = proj + (tb + 16 * wid + (lane >> 2)) * INW + OFF_RV + h * 64 + (lane & 3) * 8;
#define RT_GLDS(src, dstoff) __builtin_amdgcn_global_load_lds((const unsigned*)(src), (LAS unsigned*)(lds + (dstoff)), 16, 0, 0)
#define RT_ISSUE(ci, bo, withq) do { const size_t _o = (size_t)(ci) * RCH * INW; \
        if (withq) { RT_GLDS(qsrc + _o, (bo) + wid * 2048); RT_GLDS(qsrc + _o + (size_t)64 * INW, (bo) + wid * 2048 + 1024); } \
        RT_GLDS(ksrc + _o, (bo) + TQ + wid * 2048); RT_GLDS(ksrc + _o + (size_t)64 * INW, (bo) + TQ + wid * 2048 + 1024); \
        RT_GLDS(vsrc + _o, (bo) + 2 * TQ + wid * 1024); RT_GLDS(vsrc + _o + 32, (bo) + 2 * TQ + 8192 + wid * 1024); } while (0)
    f32x16 T[2];
#pragma unroll
    for (int kb = 0; kb < 2; ++kb)
#pragma unroll
        for (int r = 0; r < 16; ++r) T[kb][r] = 0.f;
    const int vofs = 2 * TQ + dblk * 8192 + ((lane >> 4) & 1) * 32 + (lane & 3) * 8 + (4 * hi + ((lane & 15) >> 2)) * 64;
    const int g16 = (lane >> 4) & 1, q4 = (lane & 15) >> 2, p4 = lane & 3;
    const int ktofs = TQ + (2 * g16 + (p4 >> 1)) * 2048 + (4 * hi + q4) * 16 + (p4 & 1) * 8;
    const int rowofs = (32 * a + r32) * 16;
    RT_ISSUE(0, 0, (n_pre == 0));
    for (int ci = 0; ci < total; ++ci) {
        const int bo = (ci & 1) * BUFB;
        const bool outp = (ci >= n_pre);
        asm volatile("s_waitcnt vmcnt(0)" ::: "memory");
        __builtin_amdgcn_s_barrier();
        asm volatile("" ::: "memory");
        if (ci + 1 < total) RT_ISSUE(ci + 1, BUFB - bo, (ci + 1 >= n_pre));
        if (outp) {
            f32x16 o;
#pragma unroll
            for (int r = 0; r < 16; ++r) o[r] = 0.f;
#pragma unroll
            for (int kb = 0; kb < 2; ++kb)
#pragma unroll
                for (int s = 0; s < 2; ++s) {
                    const u32x2 qa = *(const LAS u32x2*)(lds + bo + (4 * kb + 2 * s) * 2048 + rowofs + 8 * hi);
                    const u32x2 qb = *(const LAS u32x2*)(lds + bo + (4 * kb + 2 * s + 1) * 2048 + rowofs + 8 * hi);
                    const u32x4 af = (u32x4){qa.x, qa.y, qb.x, qb.y};
                    const u32x4 bf = (u32x4){cvtpk(T[kb][8 * s + 0], T[kb][8 * s + 1]), cvtpk(T[kb][8 * s + 2], T[kb][8 * s + 3]), cvtpk(T[kb][8 * s + 4], T[kb][8 * s + 5]), cvtpk(T[kb][8 * s + 6], T[kb][8 * s + 7])};
                    o = __builtin_amdgcn_mfma_f32_32x32x16_bf16(__builtin_bit_cast(bf16x8, af), __builtin_bit_cast(bf16x8, bf), o, 0, 0, 0);
                }
#pragma unroll
            for (int r = 0; r < 16; ++r) o[r] *= gC;
            bf16x8 qr[4];
#pragma unroll
            for (int d0 = 0; d0 < 4; ++d0) qr[d0] = *(const LAS bf16x8*)(lds + bo + (2 * d0 + hi) * 2048 + rowofs);
            for (int jb = 0; jb <= a; ++jb) {
                f32x16 s;
#pragma unroll
                for (int r = 0; r < 16; ++r) s[r] = 0.f;
#pragma unroll
                for (int d0 = 0; d0 < 4; ++d0) {
                    const bf16x8 kf = *(const LAS bf16x8*)(lds + bo + TQ + (2 * d0 + hi) * 2048 + (32 * jb + r32) * 16);
                    s = __builtin_amdgcn_mfma_f32_32x32x16_bf16(kf, qr[d0], s, 0, 0, 0);
                }
                if (jb == a) {
#pragma unroll
                    for (int r = 0; r < 16; ++r) if (crow(r, hi) > r32) s[r] = 0.f;
                }
                const u32x4 pa0 = (u32x4){cvtpk(s[0], s[1]), cvtpk(s[2], s[3]), cvtpk(s[4], s[5]), cvtpk(s[6], s[7])};
                const u32x4 pa1 = (u32x4){cvtpk(s[8], s[9]), cvtpk(s[10], s[11]), cvtpk(s[12], s[13]), cvtpk(s[14], s[15])};
                {
                    const v4i16_t lo = RT_TR(lds + bo + vofs + (2 * jb) * 1024), hv = RT_TR(lds + bo + vofs + (2 * jb) * 1024 + 512);
                    const bf16x8 vf = (bf16x8){lo[0], lo[1], lo[2], lo[3], hv[0], hv[1], hv[2], hv[3]};
                    o = __builtin_amdgcn_mfma_f32_32x32x16_bf16(__builtin_bit_cast(bf16x8, pa0), vf, o, 0, 0, 0);
                }
                {
                    const v4i16_t lo = RT_TR(lds + bo + vofs + (2 * jb + 1) * 1024), hv = RT_TR(lds + bo + vofs + (2 * jb + 1) * 1024 + 512);
                    const bf16x8 vf = (bf16x8){lo[0], lo[1], lo[2], lo[3], hv[0], hv[1], hv[2], hv[3]};
                    o = __builtin_amdgcn_mfma_f32_32x32x16_bf16(__builtin_bit_cast(bf16x8, pa1), vf, o, 0, 0, 0);
                }
            }
            LAS float* Y = (LAS float*)(lds + Y_OFF);
#pragma unroll
            for (int r = 0; r < 16; ++r) Y[(32 * a + crow(r, hi)) * YLD + 32 * dblk + r32] = o[r];
        }
        if (ci + 1 < total) {
#pragma unroll
            for (int kb = 0; kb < 2; ++kb)
#pragma unroll
                for (int r = 0; r < 16; ++r) T[kb][r] *= gC;
#pragma unroll
            for (int ts = 0; ts < 8; ++ts) {
                const v4i16_t vlo = RT_TR(lds + bo + vofs + ts * 1024), vhv = RT_TR(lds + bo + vofs + ts * 1024 + 512);
                const bf16x8 vf = (bf16x8){vlo[0], vlo[1], vlo[2], vlo[3], vhv[0], vhv[1], vhv[2], vhv[3]};
#pragma unroll
                for (int kb = 0; kb < 2; ++kb) {
                    const v4i16_t klo = RT_TR(lds + bo + ktofs + kb * 8192 + ts * 256), khv = RT_TR(lds + bo + ktofs + kb * 8192 + ts * 256 + 128);
                    const bf16x8 kf = (bf16x8){klo[0], klo[1], klo[2], klo[3], khv[0], khv[1], khv[2], khv[3]};
                    T[kb] = __builtin_amdgcn_mfma_f32_32x32x16_bf16(kf, vf, T[kb], 0, 0, 0);
                }
            }
        }
        if (outp) {
            asm volatile("s_waitcnt lgkmcnt(0)" ::: "memory");
            __builtin_amdgcn_s_barrier();
            asm volatile("" ::: "memory");
            const int row = tid >> 2, qd = tid & 3;
            const LAS float* yr = (const LAS float*)(lds + Y_OFF) + row * YLD + 16 * qd;
            float v[16];
#pragma unroll
            for (int i = 0; i < 4; ++i) { const f32x4 t4 = *(const LAS f32x4*)(yr + 4 * i); v[4 * i] = t4[0]; v[4 * i + 1] = t4[1]; v[4 * i + 2] = t4[2]; v[4 * i + 3] = t4[3]; }
            float s1 = 0.f;
#pragma unroll
            for (int i = 0; i < 16; ++i) s1 += v[i];
            s1 += __shfl_xor(s1, 1); s1 += __shfl_xor(s1, 2);
            const float mu = s1 * (1.0f / 64.0f);
            float s2 = 0.f;
#pragma unroll
            for (int i = 0; i < 16; ++i) { v[i] -= mu; s2 += v[i] * v[i]; }
            s2 += __shfl_xor(s2, 1); s2 += __shfl_xor(s2, 2);
            const float rstd = 1.0f / sqrtf(s2 * (1.0f / 64.0f) + EPS);
            const size_t t = tb + (size_t)ci * RCH + row;
            const u32x4 g0 = *(const u32x4*)(proj + t * INW + OFF_RG + h * 64 + 16 * qd), g1 = *(const u32x4*)(proj + t * INW + OFF_RG + h * 64 + 16 * qd + 8);
            const unsigned gw[8] = {g0.x, g0.y, g0.z, g0.w, g1.x, g1.y, g1.z, g1.w};
            unsigned ow[8];
#pragma unroll
            for (int i = 0; i < 8; ++i) {
                const float ga = bflo(gw[i]), gb = bfhi(gw[i]);
                const float oa = v[2 * i] * rstd * gn[h * 64 + 16 * qd + 2 * i] * siluf(ga), ob = v[2 * i + 1] * rstd * gn[h * 64 + 16 * qd + 2 * i + 1] * siluf(gb);
                ow[i] = cvtpk(oa, ob);
            }
            *(u32x4*)(mix + t * D + h * 64 + 16 * qd) = (u32x4){ow[0], ow[1], ow[2], ow[3]};
            *(u32x4*)(mix + t * D + h * 64 + 16 * qd + 8) = (u32x4){ow[4], ow[5], ow[6], ow[7]};
        }
    }
    asm volatile("s_waitcnt lgkmcnt(0)" ::: "memory");
    __builtin_amdgcn_s_barrier();
    asm volatile("" ::: "memory");
#undef RT_GLDS
#undef RT_ISSUE
}
#undef RT_TR
}

__device__ __forceinline__ void ph_ret(const Params& p, LAS unsigned char* lds) {
    const bf16_t* proj = (const bf16_t*)(p.ws + WS_PROJ); bf16_t* mix = (bf16_t*)(p.ws + WS_ACT);
    for (int u = blockIdx.x; u < 32 * ret::NPART; u += gridDim.x) {
        const int bh = u & 31, part = u >> 5;
        ret::unit(proj, mix, p.ret_gn, bh >> 3, bh & 7, part, lds);
    }
}

namespace dattn {
typedef short v4i16_t __attribute__((ext_vector_type(4)));
constexpr int KB_BYTES = 8192, VB_BYTES = 16384, BUF_BYTES = 2 * KB_BYTES + VB_BYTES;
constexpr int WSF_OFF = 2 * BUF_BYTES;
constexpr int LDS_NEED = WSF_OFF + 8 * 64 * 4;
__device__ __forceinline__ int crow(int r, int hi) { return (r & 3) + 8 * (r >> 2) + 4 * hi; }
__device__ __forceinline__ unsigned cvtpk(float lo, float hi) { typedef float f32x2_t __attribute__((ext_vector_type(2))); typedef __bf16 bf16x2_t __attribute__((ext_vector_type(2))); f32x2_t v = {lo, hi}; bf16x2_t b = __builtin_convertvector(v, bf16x2_t); return __builtin_bit_cast(unsigned, b); }

__device__ __forceinline__ void unit(const bf16_t* proj, bf16_t* mix, const float* subln, float lam, int b, int h, int qb, LAS unsigned char* lds) {
    const int tid = threadIdx.x, lane = tid & 63, r32 = lane & 31, hi = lane >> 5;
    const int wid = __builtin_amdgcn_readfirstlane(tid >> 6), mp = wid >> 2, rblk = wid & 3;
    const size_t tb = (size_t)b * SEQ; const int q0 = qb * 128;
    const int NTL = 2 * (qb + 1);
    const bf16_t* Kg = proj + tb * INW + OFF_DK + h * 128;
    const bf16_t* Vg = proj + tb * INW + OFF_DV + h * 128;
    const bf16_t* ksrc0 = Kg + (size_t)lane * INW + wid * 8;
    const bf16_t* ksrc1 = ksrc0 + 64;
    const bf16_t* vsrcA = Vg + (size_t)(16 * (wid & 3) + (lane >> 2)) * INW + (wid >> 2) * 32 + (lane & 3) * 8;
    const bf16_t* vsrcB = vsrcA + 64;
    LAS float* wsf = (LAS float*)(lds + WSF_OFF) + wid * 64;
#define DA_ISSUE(t, bo) do { const size_t _o = (size_t)(t) * 64 * INW; \
        __builtin_amdgcn_global_load_lds((const unsigned*)(ksrc0 + _o), (LAS unsigned*)(lds + (bo) + wid * 1024), 16, 0, 0); \
        __builtin_amdgcn_global_load_lds((const unsigned*)(ksrc1 + _o), (LAS unsigned*)(lds + (bo) + KB_BYTES + wid * 1024), 16, 0, 0); \
        __builtin_amdgcn_global_load_lds((const unsigned*)(vsrcA + _o), (LAS unsigned*)(lds + (bo) + 2 * KB_BYTES + wid * 1024), 16, 0, 0); \
        __builtin_amdgcn_global_load_lds((const unsigned*)(vsrcB + _o), (LAS unsigned*)(lds + (bo) + 2 * KB_BYTES + 8192 + wid * 1024), 16, 0, 0); } while (0)
    DA_ISSUE(0, 0);
    const bf16_t* Qw = proj + (tb + q0 + rblk * 32 + r32) * INW + OFF_DQ + h * 128 + mp * 64 + hi * 8;
    bf16x8 qr[4];
#pragma unroll
    for (int d0 = 0; d0 < 4; ++d0) qr[d0] = *(const bf16x8*)(Qw + d0 * 16);
    f32x16 o[4];
#pragma unroll
    for (int d0 = 0; d0 < 4; ++d0)
#pragma unroll
        for (int r = 0; r < 16; ++r) o[d0][r] = 0.f;
    float mrun = -INFINITY, lrun = 0.f;
    const int qrow = q0 + rblk * 32 + r32;
    const int kofs = mp * KB_BYTES + hi * 1024 + r32 * 16;
    const int vofs = 2 * KB_BYTES + ((lane >> 4) & 1) * 32 + (lane & 3) * 8 + (4 * hi + ((lane & 15) >> 2)) * 64;
    for (int t = 0; t < NTL; ++t) {
        const int bo = (t & 1) * BUF_BYTES;
        asm volatile("s_waitcnt vmcnt(0)" ::: "memory");
        __builtin_amdgcn_s_barrier();
        asm volatile("" ::: "memory");
        if (t + 1 < NTL) DA_ISSUE(t + 1, BUF_BYTES - bo);
        f32x16 p0, p1;
#pragma unroll
        for (int r = 0; r < 16; ++r) { p0[r] = 0.f; p1[r] = 0.f; }
#pragma unroll
        for (int d0 = 0; d0 < 4; ++d0) {
            const bf16x8 k0 = *(const LAS bf16x8*)(lds + bo + kofs + d0 * 2048);
            const bf16x8 k1 = *(const LAS bf16x8*)(lds + bo + kofs + d0 * 2048 + 512);
            p0 = __builtin_amdgcn_mfma_f32_32x32x16_bf16(k0, qr[d0], p0, 0, 0, 0);
            p1 = __builtin_amdgcn_mfma_f32_32x32x16_bf16(k1, qr[d0], p1, 0, 0, 0);
        }
        const int j0 = t * 64;
        if (t >= NTL - 2) {
#pragma unroll
            for (int r = 0; r < 16; ++r) { const int kv = j0 + crow(r, hi); if (kv > qrow) p0[r] = -INFINITY; if (kv + 32 > qrow) p1[r] = -INFINITY; }
        }
        float rm = fmaxf(p0[0], p1[0]);
#pragma unroll
        for (int r = 1; r < 16; ++r) rm = fmaxf(rm, fmaxf(p0[r], p1[r]));
        rm = fmaxf(rm, __shfl_xor(rm, 32));
        const float mnew = fmaxf(mrun, rm);
        const float alpha = __builtin_amdgcn_exp2f(mrun - mnew);
        mrun = mnew;
        float ps = 0.f;
#pragma unroll
        for (int r = 0; r < 16; ++r) { p0[r] = __builtin_amdgcn_exp2f(p0[r] - mnew); p1[r] = __builtin_amdgcn_exp2f(p1[r] - mnew); ps += p0[r] + p1[r]; }
        lrun = lrun * alpha + ps;
        if (hi == 0) wsf[r32] = alpha;
        asm volatile("s_waitcnt lgkmcnt(0)" ::: "memory");
        float al[16];
#pragma unroll
        for (int r = 0; r < 16; ++r) al[r] = wsf[crow(r, hi)];
#pragma unroll
        for (int d0 = 0; d0 < 4; ++d0)
#pragma unroll
            for (int r = 0; r < 16; ++r) o[d0][r] *= al[r];
        u32x4 pw[4];
        pw[0] = (u32x4){cvtpk(p0[0], p0[1]), cvtpk(p0[2], p0[3]), cvtpk(p0[4], p0[5]), cvtpk(p0[6], p0[7])};
        pw[1] = (u32x4){cvtpk(p0[8], p0[9]), cvtpk(p0[10], p0[11]), cvtpk(p0[12], p0[13]), cvtpk(p0[14], p0[15])};
        pw[2] = (u32x4){cvtpk(p1[0], p1[1]), cvtpk(p1[2], p1[3]), cvtpk(p1[4], p1[5]), cvtpk(p1[6], p1[7])};
        pw[3] = (u32x4){cvtpk(p1[8], p1[9]), cvtpk(p1[10], p1[11]), cvtpk(p1[12], p1[13]), cvtpk(p1[14], p1[15])};
#pragma unroll
        for (int d0 = 0; d0 < 4; ++d0)
#pragma unroll
            for (int ks = 0; ks < 4; ++ks) {
                const v4i16_t lo = __builtin_amdgcn_ds_read_tr16_b64_v4i16((LAS v4i16_t*)(lds + bo + vofs + d0 * 4096 + ks * 1024));
                const v4i16_t hv = __builtin_amdgcn_ds_read_tr16_b64_v4i16((LAS v4i16_t*)(lds + bo + vofs + d0 * 4096 + ks * 1024 + 512));
                const bf16x8 vf = (bf16x8){lo[0], lo[1], lo[2], lo[3], hv[0], hv[1], hv[2], hv[3]};
                o[d0] = __builtin_amdgcn_mfma_f32_32x32x16_bf16(__builtin_bit_cast(bf16x8, pw[ks]), vf, o[d0], 0, 0, 0);
            }
    }
    lrun += __shfl_xor(lrun, 32);
    if (hi == 0) wsf[32 + r32] = 1.0f / lrun;
    asm volatile("s_waitcnt lgkmcnt(0)" ::: "memory");
    float rl[16];
#pragma unroll
    for (int r = 0; r < 16; ++r) rl[r] = wsf[32 + crow(r, hi)];
#pragma unroll
    for (int d0 = 0; d0 < 4; ++d0)
#pragma unroll
        for (int r = 0; r < 16; ++r) o[d0][r] *= rl[r];
    asm volatile("s_waitcnt lgkmcnt(0)" ::: "memory");
    __builtin_amdgcn_s_barrier();
    asm volatile("" ::: "memory");
    LAS float* X = (LAS float*)lds + rblk * 4096;
    if (mp == 1) {
#pragma unroll
        for (int d0 = 0; d0 < 4; ++d0)
#pragma unroll
            for (int r = 0; r < 16; ++r) X[(d0 * 16 + r) * 64 + lane] = o[d0][r];
    }
    asm volatile("s_waitcnt lgkmcnt(0)" ::: "memory");
    __builtin_amdgcn_s_barrier();
    asm volatile("" ::: "memory");
    if (mp == 0) {
        float ss[16];
#pragma unroll
        for (int r = 0; r < 16; ++r) ss[r] = 0.f;
#pragma unroll
        for (int d0 = 0; d0 < 4; ++d0)
#pragma unroll
            for (int r = 0; r < 16; ++r) { const float dv = o[d0][r] - lam * X[(d0 * 16 + r) * 64 + lane]; o[d0][r] = dv; ss[r] += dv * dv; }
#pragma unroll
        for (int r = 0; r < 16; ++r) {
            float s = ss[r];
            s += __shfl_xor(s, 1); s += __shfl_xor(s, 2); s += __shfl_xor(s, 4); s += __shfl_xor(s, 8); s += __shfl_xor(s, 16);
            ss[r] = (1.0f - LAMBDA_INIT) / sqrtf(s * (1.0f / 128.0f) + EPS);
        }
        bf16_t* mrow = mix + (tb + q0 + rblk * 32) * D + 512 + h * 128 + r32;
#pragma unroll
        for (int d0 = 0; d0 < 4; ++d0) {
            const float g = subln[d0 * 32 + r32];
#pragma unroll
            for (int r = 0; r < 16; ++r) mrow[(size_t)crow(r, hi) * D + d0 * 32] = (bf16_t)f2bf(o[d0][r] * ss[r] * g);
        }
    }
    asm volatile("s_waitcnt lgkmcnt(0)" ::: "memory");
    __builtin_amdgcn_s_barrier();
    asm volatile("" ::: "memory");
#undef DA_ISSUE
}
}

__device__ __forceinline__ void ph_attn(const Params& p, LAS unsigned char* lds) {
    float lam;
    { float a = 0.f, bq = 0.f; for (int i = 0; i < 64; ++i) { a += p.lq1[i] * p.lk1[i]; bq += p.lq2[i] * p.lk2[i]; } lam = expf(a) - expf(bq) + LAMBDA_INIT; }
    const bf16_t* proj = (const bf16_t*)(p.ws + WS_PROJ); bf16_t* mix = (bf16_t*)(p.ws + WS_ACT);
    for (int k = 2 * (int)blockIdx.x; k < 512; k += 2 * (int)gridDim.x)
        for (int half = 0; half < 2; ++half) {
            const int uu = half ? 511 - (k >> 1) : (k >> 1);
            const int qb = 31 - uu / 16, bh = uu % 16;
            dattn::unit(proj, mix, p.subln, lam, bh >> 2, bh & 3, qb, lds);
        }
}
constexpr int NPHASE = 9;

__global__ void __launch_bounds__(NT, 2) mega(Params p) {
    extern __shared__ __attribute__((aligned(16))) unsigned char lds_raw[];
    float* sm = (float*)lds_raw;
    LAS unsigned char* lds = (LAS unsigned char*)lds_raw;
    volatile LAS unsigned* MISC = (volatile LAS unsigned*)(lds + MISC_OFF);
    if (threadIdx.x < 32) MISC[threadIdx.x] = 0u;
    __syncthreads();
    const XcdBarrier bar = xcd_barrier_post((unsigned*)(p.ws + WS_BAR), MISC + 8);
#define PH(k) (p.ph_lo <= (k) && (k) < p.ph_hi)
#define SYNC(k) do { if (PH(k) && PH((k) + 1)) xcd_barrier(bar); } while (0)
    if (PH(0)) ph_p0(p, sm, lds);
    SYNC(0);
    if (PH(1)) ph_p1(p);
    SYNC(1);
    if (PH(2)) ph_p2(p, lds);
    SYNC(2);
    if (PH(3)) { ph_ret(p, lds); ph_attn(p, lds); }
    SYNC(3);
    if (PH(4)) ph_p4(p, lds);
    SYNC(4);
    if (PH(5)) ph_p5(p, sm);
    SYNC(5);
    if (PH(6)) ph_p6(p, lds);
    SYNC(6);
    if (PH(7)) ph_p7(p, lds);
    SYNC(7);
    if (PH(8)) ph_p8(p, lds);
#undef PH
#undef SYNC
}

#ifndef N_LAUNCHES
#define N_LAUNCHES 1
#endif

extern "C" void kernel_launch(void* const* d_in, const int* in_sizes, int n_in, void* d_out, int out_size, void* d_ws, size_t ws_size, hipStream_t stream) {
    static int grid = 0;
    if (grid == 0) {
        if (n_in != 22 || in_sizes[0] != M * D || out_size != M * D || ws_size < WS_END) {
            fprintf(stderr, "kernel_launch: unexpected shapes (n_in %d, in0 %d, out %d, ws %zu)\n", n_in, n_in > 0 ? in_sizes[0] : -1, out_size, ws_size); grid = -1; return; }
        int dev = 0, cus = 0, per_cu = 0;
        (void)hipGetDevice(&dev);
        (void)hipDeviceGetAttribute(&cus, hipDeviceAttributeMultiprocessorCount, dev);
        (void)hipFuncSetAttribute((const void*)mega, hipFuncAttributeMaxDynamicSharedMemorySize, LDS_BYTES);
        (void)hipOccupancyMaxActiveBlocksPerMultiprocessor(&per_cu, (const void*)mega, NT, LDS_BYTES);
        if (per_cu < 1) { fprintf(stderr, "kernel_launch: occupancy query says %d\n", per_cu); grid = -1; return; }
        grid = cus;
    }
    if (grid < 0) return;
    (void)hipMemsetAsync((char*)d_ws + WS_BAR, 0, 16384, stream);
    Params p{};
    const float** f = (const float**)&p;
    for (int i = 0; i < 22; ++i) f[i] = (const float*)d_in[i];
    p.out = (float*)d_out; p.ws = (unsigned char*)d_ws;
    if (N_LAUNCHES == 1) {
        p.ph_lo = 0; p.ph_hi = NPHASE;
        void* args[] = {&p};
        hipError_t e = hipLaunchCooperativeKernel((void*)mega, dim3(grid), dim3(NT), args, LDS_BYTES, stream);
        if (e != hipSuccess) fprintf(stderr, "cooperative launch failed: %s (grid %d)\n", hipGetErrorString(e), grid);
    } else {
        for (int k = 0; k < NPHASE; ++k) { p.ph_lo = k; p.ph_hi = k + 1; hipLaunchKernelGGL(mega, dim3(grid), dim3(NT), LDS_BYTES, stream, p); }
    }
}
```

```cpp
#include <hip/hip_runtime.h>
#include <hip/hip_cooperative_groups.h>
#include <cstdio>
#include <cstdint>
#include <cmath>
namespace cg = cooperative_groups;

constexpr int D = 1024, NB = 4, SEQ = 4096, M = NB * SEQ;
constexpr int INW = 3584;
constexpr int OFF_RQ = 0, OFF_RK = 512, OFF_RV = 1024, OFF_RG = 1536, OFF_DQ = 2048, OFF_DK = 2560, OFF_DV = 3072;
constexpr int NEXP = 32, DE = 512, NMODW = 6 * D;
constexpr float EPS = 1e-6f;
constexpr float LAMBDA_INIT = 0.2f;
constexpr float LOG2E = 1.4426950408889634f;
constexpr float C2 = 0.125f * LOG2E;
constexpr int NT = 512;
constexpr int LISTCAP = 16384;
constexpr int RCH = 128;

#define LAS __attribute__((address_space(3)))
typedef unsigned short bf16_t;
typedef short bf16x8 __attribute__((ext_vector_type(8)));
typedef float f32x4 __attribute__((ext_vector_type(4)));
typedef float f32x16 __attribute__((ext_vector_type(16)));
typedef unsigned u32x4 __attribute__((ext_vector_type(4)));
typedef unsigned u32x2 __attribute__((ext_vector_type(2)));

__device__ __forceinline__ float siluf(float v) { return v / (1.0f + __expf(-v)); }
__device__ __forceinline__ float wave_sum(float v) {
#pragma unroll
    for (int o = 1; o < 64; o <<= 1) v += __shfl_xor(v, o);
    return v;
}
__device__ __forceinline__ unsigned f2bf(float f) { unsigned u = __builtin_bit_cast(unsigned, f); return (u + 0x7fffu + ((u >> 16) & 1u)) >> 16; }
__device__ __forceinline__ unsigned pk2(float lo, float hi) { return f2bf(lo) | (f2bf(hi) << 16); }
__device__ __forceinline__ float bf2f(bf16_t v) { return __builtin_bit_cast(float, (unsigned)v << 16); }
__device__ __forceinline__ float bflo(unsigned w) { return __builtin_bit_cast(float, w << 16); }
__device__ __forceinline__ float bfhi(unsigned w) { return __builtin_bit_cast(float, w & 0xffff0000u); }
__device__ __forceinline__ unsigned ld_cnt(const unsigned* p) { return __hip_atomic_load(p, __ATOMIC_RELAXED, __HIP_MEMORY_SCOPE_AGENT); }

__device__ __forceinline__ void glds16(const void* gsrc, unsigned lds_dst) { unsigned keep;
    asm volatile("s_mov_b32 %0, m0\n\ts_mov_b32 m0, %2\n\ts_nop 0\n\tglobal_load_lds_dwordx4 %1, off\n\ts_mov_b32 m0, %0" : "=&s"(keep) : "v"(gsrc), "s"(lds_dst) : "memory"); }

typedef __attribute__((address_space(1))) unsigned gu32;
#define XB_TMO      128
#define XB_XCNT(j)  (256  + 64 * (j))
#define XB_XSUB(j)  (1280 + 64 * (j))
#define XB_XGEN(j)  (2304 + 64 * (j))
#define XB_TOP      3328
#define XB_TOPGEN   3392
#define XCD_BAR_WORDS 3456
#define XB_SPIN_CAP (1u << 18)

__device__ __forceinline__ unsigned xb_ld(unsigned* p)              { return __hip_atomic_load(p, __ATOMIC_RELAXED, __HIP_MEMORY_SCOPE_AGENT); }
__device__ __forceinline__ unsigned xb_add(unsigned* p, unsigned v) { return __hip_atomic_fetch_add(p, v, __ATOMIC_RELAXED, __HIP_MEMORY_SCOPE_AGENT); }
__device__ __forceinline__ unsigned xb_xcc_id() { return (unsigned)__builtin_amdgcn_s_getreg((3 << 11) | 20) & 0xFu; }
#define XB_SPIN(cond, bar) do { unsigned _sp = 0; while (cond) { __builtin_amdgcn_s_sleep(1); \
    if ((++_sp & 255u) == 0u) { if (xb_ld(&(bar)[XB_TMO])) break; if (_sp > XB_SPIN_CAP) { atomicAdd(&(bar)[XB_TMO], 1u); break; } } } } while (0)

struct XcdBarrier {
    unsigned* bar; unsigned x;
    volatile LAS unsigned* st;
};

__device__ __forceinline__ XcdBarrier xcd_barrier_post(unsigned* bar, volatile LAS unsigned* st) {
    XcdBarrier b; b.bar = bar; b.x = xb_xcc_id(); b.st = st;
    if (threadIdx.x == 0) (void)xb_add(&bar[XB_XCNT(b.x)], 1u);
    return b;
}
__device__ __forceinline__ void xcd_barrier_complete(unsigned* bar, unsigned x, unsigned& nloc, unsigned& nx) {
    const unsigned G = gridDim.x * gridDim.y * gridDim.z;
    unsigned sum, cnt, mine, sp = 0u;
    for (;;) {
        sum = 0u; cnt = 0u; mine = 0u;
#pragma unroll
        for (unsigned j = 0; j < 16; ++j) { const unsigned c = xb_ld(&bar[XB_XCNT(j)]); sum += c; cnt += (c > 0u) ? 1u : 0u; mine = (j == x) ? c : mine; }
        if (sum == G) break;
        __builtin_amdgcn_s_sleep(1);
        if ((++sp & 255u) == 0u) { if (xb_ld(&bar[XB_TMO])) break; if (sp > XB_SPIN_CAP) { atomicAdd(&bar[XB_TMO], 1u); break; } }
    }
    nloc = mine > 0u ? mine : 1u; nx = cnt > 0u ? cnt : 1u;
}

__device__ __forceinline__ void xcd_barrier(const XcdBarrier& b) {
    asm volatile("s_waitcnt vmcnt(0)" ::: "memory");
    __syncthreads();
    if (threadIdx.x == 0) {
        unsigned* bar = b.bar;
        __builtin_amdgcn_s_waitcnt(0);
        unsigned nloc = b.st[0], nx = b.st[1];
        if (nloc == 0u) { xcd_barrier_complete(bar, b.x, nloc, nx); b.st[0] = nloc; b.st[1] = nx; }
        const unsigned old = xb_add(&bar[XB_XSUB(b.x)], 1u);
        const unsigned gen = old / nloc;
        if (old + 1u == (gen + 1u) * nloc) {
            __builtin_amdgcn_fence(__ATOMIC_RELEASE, "agent");
            asm volatile("s_waitcnt vmcnt(0)" ::: "memory");
            const unsigned og = xb_add(&bar[XB_TOP], 1u);
            const unsigned tg = og / nx;
            if (og + 1u == (tg + 1u) * nx) xb_add(&bar[XB_TOPGEN], 1u);
            else XB_SPIN(xb_ld(&bar[XB_TOPGEN]) == tg, bar);
            __builtin_amdgcn_fence(__ATOMIC_ACQUIRE, "agent");
            xb_add(&bar[XB_XGEN(b.x)], 1u);
            asm volatile("s_waitcnt vmcnt(0)" ::: "memory");
        } else {
            XB_SPIN(xb_ld(&bar[XB_XGEN(b.x)]) == gen, bar);
            __builtin_amdgcn_fence(__ATOMIC_ACQUIRE, "agent");
            asm volatile("s_waitcnt vmcnt(0)" ::: "memory");
        }
    }
    __syncthreads();
}
namespace pg8 {
constexpr int BM = 256, BK = 64, HALF = 128, HTB = HALF * BK * 2  , STAGE_BYTES = 8 * HTB;

__host__ __device__ __forceinline__ int lds_byte(int r, int c) { const int st = (r >> 4) * 2 + (c >> 5), rr = r & 15, cc = c & 31, ob = rr * 64 + cc * 2; return st * 1024 + (ob ^ (((ob >> 9) & 1) << 5)); }
__host__ __device__ __forceinline__ void stage_rc(int b, int& R, int& C) { const int st = b / 1024, sb = b % 1024, swz = sb ^ (((sb >> 9) & 1) << 5); R = (st >> 1) * 16 + swz / 64; C = (st & 1) * 32 + (swz % 64) / 2; }
__host__ __device__ __forceinline__ int perm32(int rho) { const int n = rho >> 4, i = rho & 15; return 8 * (i >> 2) + 4 * n + (i & 3); }

struct Unit { const char* a; const char* b; const int* rows; int nvalid; int pm, pn, aux; };

__device__ __forceinline__ unsigned cvt_pk_bf16(float lo, float hi) { typedef float f32x2_t __attribute__((ext_vector_type(2))); typedef __bf16 bf16x2_t __attribute__((ext_vector_type(2))); f32x2_t v = {lo, hi}; bf16x2_t b = __builtin_convertvector(v, bf16x2_t); return __builtin_bit_cast(unsigned, b); }

template <class Epi, class Sched, bool ALIGN_EPI, bool GATHER>
__device__ __forceinline__ void gemm_phase(LAS unsigned char* lds, const int K, const Sched& S, const Epi& E) {
    const int tid = threadIdx.x, wid = __builtin_amdgcn_readfirstlane(tid >> 6), lane = tid & 63, wr = wid >> 2, wc = wid & 3, fr = lane & 15, fq = lane >> 4;
    const int nt = K / BK;
    int Rr[2], Cc[2]; unsigned voffB[2];
#pragma unroll
    for (int i = 0; i < 2; ++i) { int R, C; stage_rc(tid * 16 + i * 8192, R, C); const int Rb = Epi::PERM ? ((R & ~31) + perm32(R & 31)) : R;
        Rr[i] = R; Cc[i] = C; voffB[i] = (unsigned)(Rb * K + C) * 2u; }
    const size_t kstep = (size_t)(BK * 2);
    const size_t hstep = (size_t)HALF * K * 2;
    const unsigned ldsw = (unsigned)wid * 1024u;
    const int aoff = lds_byte(wr * 64 + fr, fq * 8), boff = lds_byte(wc * 32 + fr, fq * 8);
#define PG8_SA(b, h) (((b) * 2 + (h)) * HTB)
#define PG8_SB(b, h) ((4 + (b) * 2 + (h)) * HTB)
#define PG8_STAGE(bufoff, gbase, voff) do { _Pragma("unroll") for (int _i = 0; _i < 2; ++_i) \
        __builtin_amdgcn_global_load_lds((const unsigned*)((const char*)(gbase) + (voff)[_i]), (LAS unsigned*)(lds + (bufoff) + ldsw + _i * 8192), 16, 0, 0); } while (0)
#define PG8_LDA(dst, b, h) do { _Pragma("unroll") for (int m = 0; m < 4; ++m) _Pragma("unroll") for (int k = 0; k < 2; ++k) dst[m][k] = *(const LAS bf16x8*)(lds + PG8_SA(b, h) + aoff + m * 2048 + k * 1024); } while (0)
#define PG8_LDB(dst, b, h) do { _Pragma("unroll") for (int n = 0; n < 2; ++n) _Pragma("unroll") for (int k = 0; k < 2; ++k) dst[n][k] = *(const LAS bf16x8*)(lds + PG8_SB(b, h) + boff + n * 2048 + k * 1024); } while (0)
#define PG8_MMA(ai, bj, At, Bt) do { __builtin_amdgcn_s_setprio(1); _Pragma("unroll") for (int m = 0; m < 4; ++m) _Pragma("unroll") for (int n = 0; n < 2; ++n) _Pragma("unroll") for (int k = 0; k < 2; ++k) \
        acc[ai][bj][m][n] = __builtin_amdgcn_mfma_f32_16x16x32_bf16(Bt[n][k], At[m][k], acc[ai][bj][m][n], 0, 0, 0); __builtin_amdgcn_s_setprio(0); } while (0)
#define PG8_WAIT_V(n) asm volatile("s_waitcnt vmcnt(" #n ")" ::: "memory")
#define PG8_WAIT_L(n) asm volatile("s_waitcnt lgkmcnt(" #n ")" ::: "memory")
#define PG8_BAR __builtin_amdgcn_s_barrier()
#define PG8_SCHED __builtin_amdgcn_sched_barrier(0)
#define PG8_MKA(u, v0, v1) do { _Pragma("unroll") for (int _i = 0; _i < 2; ++_i) { \
        if (GATHER) { const int _l = (u).nvalid - 1; const int _r0 = Rr[_i] < _l ? Rr[_i] : _l, _r1 = (Rr[_i] + HALF) < _l ? (Rr[_i] + HALF) : _l; \
            (v0)[_i] = (unsigned)((u).rows[_r0] * K + Cc[_i]) * 2u; (v1)[_i] = (unsigned)((u).rows[_r1] * K + Cc[_i]) * 2u; } \
        else { (v0)[_i] = (unsigned)(Rr[_i] * K + Cc[_i]) * 2u; (v1)[_i] = (v0)[_i] + (unsigned)(HALF * K * 2); } } } while (0)
    Unit cur, nxt; int ui = 0;
    if (!S.next(0, cur)) return;
    f32x4 acc[2][2][4][2];
#pragma unroll
    for (int a = 0; a < 2; ++a)
#pragma unroll
        for (int b = 0; b < 2; ++b)
#pragma unroll
            for (int m = 0; m < 4; ++m)
#pragma unroll
                for (int n = 0; n < 2; ++n) acc[a][b][m][n] = (f32x4){0.f, 0.f, 0.f, 0.f};
    bf16x8 At[4][2], B0[2][2], B1[2][2];
    const char* cA = cur.a; const char* cB = cur.b;
    unsigned vA0[2], vA1[2], nA0[2], nA1[2];
    PG8_MKA(cur, vA0, vA1);
    PG8_STAGE(PG8_SB(0, 0), cB, voffB); PG8_STAGE(PG8_SB(0, 1), cB + hstep, voffB); PG8_STAGE(PG8_SA(0, 0), cA, vA0); PG8_STAGE(PG8_SA(0, 1), cA, vA1);
    if (wr == 1) PG8_BAR;
    PG8_WAIT_V(2); PG8_BAR;
    PG8_STAGE(PG8_SB(1, 0), cB + kstep, voffB); PG8_STAGE(PG8_SA(1, 0), cA + kstep, vA0); PG8_STAGE(PG8_SB(1, 1), cB + hstep + kstep, voffB);
    PG8_WAIT_V(6); PG8_BAR;
    for (;;) {
        const bool has_next = S.next(ui + 1, nxt);
        const char* nA = has_next ? nxt.a : cA; const char* nB = has_next ? nxt.b : cB;
        if (has_next) { PG8_MKA(nxt, nA0, nA1); } else { nA0[0] = vA0[0]; nA0[1] = vA0[1]; nA1[0] = vA1[0]; nA1[1] = vA1[1]; }
        for (int t = 0; t < nt; t += 2) {
            const bool last = (t == nt - 2);
            const char* a1 = cA + (size_t)(t + 1) * kstep;
            const char* a2 = last ? nA : cA + (size_t)(t + 2) * kstep; const char* b2 = last ? nB : cB + (size_t)(t + 2) * kstep;
            const char* a3 = a2 + kstep; const char* b3 = b2 + kstep;
            unsigned x0[2], x1[2];
            x0[0] = last ? nA0[0] : vA0[0]; x0[1] = last ? nA0[1] : vA0[1]; x1[0] = last ? nA1[0] : vA1[0]; x1[1] = last ? nA1[1] : vA1[1];
            PG8_LDB(B0, 0, 0); PG8_LDB(B1, 0, 1); PG8_SCHED; PG8_LDA(At, 0, 0); PG8_STAGE(PG8_SA(1, 1), a1, vA1);
            PG8_WAIT_V(8); PG8_WAIT_L(0); PG8_BAR; PG8_MMA(0, 0, At, B0); PG8_MMA(0, 1, At, B1); PG8_BAR; PG8_SCHED;
            PG8_LDA(At, 0, 1); PG8_STAGE(PG8_SB(0, 0), b2, voffB); PG8_STAGE(PG8_SB(0, 1), b2 + hstep, voffB); PG8_STAGE(PG8_SA(0, 0), a2, x0);
            PG8_WAIT_V(8); PG8_WAIT_L(0); PG8_BAR; PG8_MMA(1, 0, At, B0); PG8_MMA(1, 1, At, B1); PG8_BAR; PG8_SCHED;
            PG8_LDB(B0, 1, 0); PG8_LDB(B1, 1, 1); PG8_SCHED; PG8_LDA(At, 1, 0); PG8_STAGE(PG8_SA(0, 1), a2, x1);
            PG8_WAIT_V(8); PG8_WAIT_L(0); PG8_BAR; PG8_MMA(0, 0, At, B0); PG8_MMA(0, 1, At, B1); PG8_BAR; PG8_SCHED;
            PG8_LDA(At, 1, 1); PG8_STAGE(PG8_SB(1, 0), b3, voffB); PG8_STAGE(PG8_SB(1, 1), b3 + hstep, voffB); PG8_STAGE(PG8_SA(1, 0), a3, x0);
            PG8_WAIT_V(8); PG8_WAIT_L(0); PG8_BAR; PG8_MMA(1, 0, At, B0); PG8_MMA(1, 1, At, B1); PG8_BAR; PG8_SCHED;
        }
        if constexpr (ALIGN_EPI) { if (wr == 0) PG8_BAR; }
        E(acc, cur, wr, wc, fr, fq);
        if (!has_next) break;
#pragma unroll
        for (int a = 0; a < 2; ++a)
#pragma unroll
            for (int b = 0; b < 2; ++b)
#pragma unroll
                for (int m = 0; m < 4; ++m)
#pragma unroll
                    for (int n = 0; n < 2; ++n) acc[a][b][m][n] = (f32x4){0.f, 0.f, 0.f, 0.f};
        cur = nxt; cA = nA; cB = nB; ++ui;
        vA0[0] = nA0[0]; vA0[1] = nA0[1]; vA1[0] = nA1[0]; vA1[1] = nA1[1];
        if constexpr (ALIGN_EPI) { if (wr == 1) PG8_BAR; }
    }
    PG8_WAIT_V(0);
    if constexpr (!ALIGN_EPI) { if (wr == 0) PG8_BAR; }
    PG8_BAR;
#undef PG8_SA
#undef PG8_SB
#undef PG8_STAGE
#undef PG8_LDA
#undef PG8_LDB
#undef PG8_MMA
#undef PG8_WAIT_V
#undef PG8_WAIT_L
#undef PG8_BAR
#undef PG8_SCHED
#undef PG8_MKA
}
}

struct StaticSched {
    const char* A; const char* Bt; int K, nM, nN, nwg, G, c;
    __device__ __forceinline__ void init(const void* A_, const void* Bt_, int Mrows, int N, int K_, int G_, int c_) { A = (const char*)A_; Bt = (const char*)Bt_; K = K_; nM = Mrows / 256; nN = N / 256; nwg = nM * nN; G = G_; c = c_; }
    __device__ __forceinline__ bool next(int i, pg8::Unit& u) const {
        const long L = (long)i * G + c; if (L >= nwg) return false;
        int wgid = (int)L; { const int q = nwg / 8, r = nwg % 8, xcd = wgid % 8, off = wgid / 8; wgid = (xcd < r ? xcd * (q + 1) : r * (q + 1) + (xcd - r) * q) + off; }
        const int nig = 8 * nN, gid = wgid / nig, fm = gid * 8, gsz = (nM - fm) < 8 ? (nM - fm) : 8;
        u.pm = fm + ((wgid % nig) % gsz); u.pn = (wgid % nig) / gsz; u.aux = 0; u.rows = nullptr; u.nvalid = 256;
        u.a = A + (size_t)u.pm * 256 * K * 2; u.b = Bt + (size_t)u.pn * 256 * K * 2; return true;
    }
};

struct EpiProj {
    static constexpr bool PERM = true;
    bf16_t* proj; const float* rc; const float* rs;
    __device__ __forceinline__ void operator()(const f32x4 (&acc)[2][2][4][2], const pg8::Unit& u, int wr, int wc, int fr, int fq) const {
        const int row0 = u.pm * 256 + wr * 64 + fr, col0 = u.pn * 256 + wc * 32 + 8 * fq;
        const int kind = (u.pn < 2) ? 1 : (u.pn < 4) ? 2 : (u.pn == 8 || u.pn == 9) ? 3 : 0;
#pragma unroll
        for (int ai = 0; ai < 2; ++ai)
#pragma unroll
            for (int m = 0; m < 4; ++m) {
                const int row = row0 + ai * 128 + m * 16; const int pos = row & (SEQ - 1);
                bf16_t* rowp = proj + (size_t)row * INW + col0;
#pragma unroll
                for (int bj = 0; bj < 2; ++bj) {
                    f32x4 v0 = acc[ai][bj][m][0], v1 = acc[ai][bj][m][1];
                    if (kind == 1 || kind == 2) {
                        const int c = col0 + bj * 128; const int d0 = (c & 63) >> 1; const int h = (c & 511) >> 6;
                        const f32x4 cs = *(const f32x4*)(rc + pos * 32 + d0), sn = *(const f32x4*)(rs + pos * 32 + d0);
                        const float lg2 = log2f(1.0f - exp2f(-5.0f - (float)h));
                        const float il = (float)(pos & (RCH - 1));
                        const float sc = (kind == 1) ? exp2f(lg2 * il) : 0.125f * exp2f(-lg2 * il);
                        f32x4 o0, o1;
                        o0[0] = (v0[0] * cs[0] - v0[1] * sn[0]) * sc; o0[1] = (v0[1] * cs[0] + v0[0] * sn[0]) * sc;
                        o0[2] = (v0[2] * cs[1] - v0[3] * sn[1]) * sc; o0[3] = (v0[3] * cs[1] + v0[2] * sn[1]) * sc;
                        o1[0] = (v1[0] * cs[2] - v1[1] * sn[2]) * sc; o1[1] = (v1[1] * cs[2] + v1[0] * sn[2]) * sc;
                        o1[2] = (v1[2] * cs[3] - v1[3] * sn[3]) * sc; o1[3] = (v1[3] * cs[3] + v1[2] * sn[3]) * sc;
                        v0 = o0; v1 = o1;
                    } else if (kind == 3) { v0 = v0 * C2; v1 = v1 * C2; }
                    u32x4 w; w.x = pg8::cvt_pk_bf16(v0[0], v0[1]); w.y = pg8::cvt_pk_bf16(v0[2], v0[3]); w.z = pg8::cvt_pk_bf16(v1[0], v1[1]); w.w = pg8::cvt_pk_bf16(v1[2], v1[3]);
                    *(u32x4*)(rowp + bj * 128) = w;
                }
            }
    }
};

template <class RowMap>
__device__ __forceinline__ void transpose64(const float* src_lane, size_t ld, bf16_t* dst_k0, int dstK, RowMap rowmap, LAS float* scr, int lane) {
#pragma unroll 16
    for (int kk = 0; kk < 64; ++kk) scr[kk * 65 + lane] = src_lane[(size_t)kk * ld];
    asm volatile("s_waitcnt lgkmcnt(0)" ::: "memory");
    const int c = lane & 7;
#pragma unroll
    for (int jj = 0; jj < 8; ++jj) {
        const int slot = (lane >> 3) + 8 * jj; const LAS float* s = scr + (8 * c) * 65 + slot;
        u32x4 o; o.x = pk2(s[0 * 65], s[1 * 65]); o.y = pk2(s[2 * 65], s[3 * 65]); o.z = pk2(s[4 * 65], s[5 * 65]); o.w = pk2(s[6 * 65], s[7 * 65]);
        *(u32x4*)(dst_k0 + (size_t)rowmap(slot) * dstK + 8 * c) = o;
    }
    asm volatile("s_waitcnt lgkmcnt(0)" ::: "memory");
}

struct EpiRes {
    static constexpr bool PERM = false;
    const float* x; const float* mod; float* x1;
    __device__ __forceinline__ void operator()(const f32x4 (&acc)[2][2][4][2], const pg8::Unit& u, int wr, int wc, int fr, int fq) const {
        const int row0 = u.pm * 256 + wr * 64 + fr, col0 = u.pn * 256 + wc * 32 + 4 * fq;
        const int b = row0 >> 12;
        f32x4 gv[2][2];
#pragma unroll
        for (int bj = 0; bj < 2; ++bj)
#pragma unroll
            for (int n = 0; n < 2; ++n) gv[bj][n] = *(const f32x4*)(mod + b * NMODW + 2 * D + col0 + bj * 128 + n * 16);
#pragma unroll
        for (int ai = 0; ai < 2; ++ai)
#pragma unroll
            for (int m = 0; m < 4; ++m) {
                const size_t off = (size_t)(row0 + ai * 128 + m * 16) * D + col0;
#pragma unroll
                for (int bj = 0; bj < 2; ++bj)
#pragma unroll
                    for (int n = 0; n < 2; ++n) {
                        const f32x4 xv = *(const f32x4*)(x + off + bj * 128 + n * 16);
                        *(f32x4*)(x1 + off + bj * 128 + n * 16) = xv + gv[bj][n] * acc[ai][bj][m][n];
                    }
                if (m & 1) asm volatile("" ::: "memory");
            }
    }
};

struct EpiHid {
    static constexpr bool PERM = true;
    bf16_t* hid; const int* list; const float* listw;
    __device__ __forceinline__ void operator()(const f32x4 (&acc)[2][2][4][2], const pg8::Unit& u, int wr, int wc, int fr, int fq) const {
        const int rl0 = wr * 64 + fr; const int f0 = u.pn * 128 + wc * 16 + fq * 4;
        const float* lw = listw + (u.rows - list);
#pragma unroll
        for (int ai = 0; ai < 2; ++ai)
#pragma unroll
            for (int m = 0; m < 4; ++m) {
                const int rl = rl0 + ai * 128 + m * 16;
                const float w = (rl < u.nvalid) ? lw[rl] : 0.f;
                bf16_t* rowp = hid + (size_t)(u.pm + rl) * DE + f0;
#pragma unroll
                for (int bj = 0; bj < 2; ++bj) {
                    const f32x4 g = acc[ai][bj][m][0], up = acc[ai][bj][m][1];
                    u32x2 o; o.x = pg8::cvt_pk_bf16(siluf(g[0]) * up[0] * w, siluf(g[1]) * up[1] * w); o.y = pg8::cvt_pk_bf16(siluf(g[2]) * up[2] * w, siluf(g[3]) * up[3] * w);
                    *(u32x2*)(rowp + bj * 64) = o;
                }
            }
    }
};

struct EpiY {
    static constexpr bool PERM = true;
    bf16_t* y;
    __device__ __forceinline__ void operator()(const f32x4 (&acc)[2][2][4][2], const pg8::Unit& u, int wr, int wc, int fr, int fq) const {
        const int rl0 = wr * 64 + fr; const int col0 = u.pn * 256 + wc * 32 + 8 * fq;
#pragma unroll
        for (int ai = 0; ai < 2; ++ai)
#pragma unroll
            for (int m = 0; m < 4; ++m) {
                bf16_t* rowp = y + (size_t)(u.pm + rl0 + ai * 128 + m * 16) * D + col0;
#pragma unroll
                for (int bj = 0; bj < 2; ++bj) {
                    const f32x4 v0 = acc[ai][bj][m][0], v1 = acc[ai][bj][m][1];
                    u32x4 w; w.x = pg8::cvt_pk_bf16(v0[0], v0[1]); w.y = pg8::cvt_pk_bf16(v0[2], v0[3]); w.z = pg8::cvt_pk_bf16(v1[0], v1[1]); w.w = pg8::cvt_pk_bf16(v1[2], v1[3]);
                    *(u32x4*)(rowp + bj * 128) = w;
                }
            }
    }
};

struct MoeSched {
    const LAS int* tab; const char* A; const char* Bt; const int* list; int K, bexp  , gather, G, c;
    __device__ __forceinline__ bool next(int i, pg8::Unit& u) const {
        const int L = i * G + c; if (L >= tab[96]) return false;
        int e = 0;
#pragma unroll 1
        for (int q = 1; q < NEXP; ++q) if (tab[64 + q] <= L) e = q;
        const int li = L - tab[64 + e], mt = li >> 2, pn = li & 3, cnt = tab[e], off = tab[32 + e];
        u.pm = off + mt * 256; u.pn = pn; u.aux = e; u.nvalid = cnt - mt * 256; u.rows = list + e * LISTCAP + mt * 256;
        u.a = gather ? A : A + (size_t)u.pm * K * 2; u.b = Bt + (size_t)e * bexp + (size_t)pn * 256 * K * 2; return true;
    }
};
__device__ __forceinline__ void moe_table(const unsigned* cnt, LAS int* tab) {
    if (threadIdx.x == 0) { int off = 0, ub = 0;
        for (int e = 0; e < NEXP; ++e) { const int c = (int)ld_cnt(cnt + e * 32); tab[e] = c; tab[32 + e] = off; tab[64 + e] = ub; off += ((c + 255) >> 8) << 8; ub += ((c + 255) >> 8) * 4; }
        tab[96] = ub; }
    __syncthreads();
}

constexpr size_t MiB = 1u << 20;
constexpr size_t WS_MOD = 0;
constexpr size_t WS_ROPE_C = 128 * 1024;
constexpr size_t WS_ROPE_S = WS_ROPE_C + 512 * 1024;
constexpr size_t WS_CNT = WS_ROPE_S + 512 * 1024;
constexpr size_t WS_TOKSLOT = 2 * MiB;
constexpr size_t WS_LIST = 3 * MiB;
constexpr size_t WS_LISTW = 5 * MiB;
constexpr size_t WS_BAR = 7 * MiB;
constexpr size_t WS_RFLAG = 7 * MiB + 16384;
constexpr size_t WS_RSTATE = 266 * MiB;
constexpr size_t WS_WIN = 8 * MiB;
constexpr size_t WS_WO = 15 * MiB;
constexpr size_t WS_WGU = 17 * MiB;
constexpr size_t WS_WD = 81 * MiB;
constexpr size_t WS_ACT = 113 * MiB;
constexpr size_t WS_PROJ = 145 * MiB;
constexpr size_t WS_HID = 145 * MiB;
constexpr size_t WS_Y = 185 * MiB;
constexpr size_t WS_END = 270 * MiB;
static_assert(WS_PROJ + (size_t)M * INW * 2 <= WS_END, "ws map");

constexpr int LDS_BYTES = 147456;
constexpr int RING_BYTES = 131072;
constexpr int TAB_OFF = 140 * 1024;
constexpr int MISC_OFF = 142 * 1024;

struct Params {
    const float *x, *c, *ada_w, *ada_b, *g1, *g2, *w_in, *w_out, *ret_gn, *lq1, *lk1, *lq2, *lk2, *subln;
    const float *w_group, *b_group, *w_expert, *b_expert, *w_gate, *w_up, *w_down, *final_gain;
    float* out; unsigned char* ws;
    int ph_lo, ph_hi;
};

__device__ __forceinline__ void ph_p0(const Params& p, float* sm, LAS unsigned char* lds) {
    const int tid = threadIdx.x;
    float* mod = (float*)(p.ws + WS_MOD);
    float* csil = sm;
    float* red = sm + 4096;
    for (int i = tid; i < 4096; i += NT) csil[i] = siluf(p.c[i]);
    __syncthreads();
    const int col = tid & 31, ks = tid >> 5;
    for (int it = blockIdx.x; it < NMODW / 32; it += gridDim.x) {
        const int n0 = it * 32;
        float a0 = 0.f, a1 = 0.f, a2 = 0.f, a3 = 0.f;
        for (int k = ks * 64; k < ks * 64 + 64; ++k) {
            const float w = p.ada_w[(size_t)k * NMODW + n0 + col];
            a0 += csil[k] * w; a1 += csil[1024 + k] * w; a2 += csil[2048 + k] * w; a3 += csil[3072 + k] * w;
        }
        red[(ks * 4 + 0) * 32 + col] = a0; red[(ks * 4 + 1) * 32 + col] = a1; red[(ks * 4 + 2) * 32 + col] = a2; red[(ks * 4 + 3) * 32 + col] = a3;
        __syncthreads();
        if (tid < 128) {
            const int b = tid >> 5, cc = tid & 31;
            float s = p.ada_b[n0 + cc];
            for (int q = 0; q < 16; ++q) s += red[(q * 4 + b) * 32 + cc];
            mod[b * NMODW + n0 + cc] = s;
        }
        __syncthreads();
    }
    float* rc = (float*)(p.ws + WS_ROPE_C); float* rs = (float*)(p.ws + WS_ROPE_S);
    for (int i = blockIdx.x * NT + tid; i < SEQ * 32; i += gridDim.x * NT) {
        const int pos = i >> 5, d = i & 31;
        const float inv = 1.0f / powf(10000.0f, (float)d / 32.0f);
        const float ang = (float)pos * inv;
        const double tq = (double)ang * 0.15915494309189535;
        const float fr = (float)(tq - rint(tq));
        rc[i] = __builtin_amdgcn_cosf(fr); rs[i] = __builtin_amdgcn_sinf(fr);
    }
    if (blockIdx.x == 0) for (int i = tid; i < NEXP * 32; i += NT) ((unsigned*)(p.ws + WS_CNT))[i] = 0u;
    __syncthreads();
    const int lane = tid & 63, wave = tid >> 6;
    LAS float* scr = (LAS float*)(lds + wave * 16640);
    bf16_t* WinT = (bf16_t*)(p.ws + WS_WIN); bf16_t* WoT = (bf16_t*)(p.ws + WS_WO); bf16_t* WguT = (bf16_t*)(p.ws + WS_WGU); bf16_t* WdT = (bf16_t*)(p.ws + WS_WD);
    constexpr int I_IN = 16 * 56, I_O = 16 * 16, I_GU = NEXP * 256, I_D = NEXP * 128;
    for (int it = blockIdx.x * 8 + wave; it < I_IN + I_O + I_GU + I_D; it += gridDim.x * 8) {
        int r = it;
        if (r < I_IN) {
            const int kb = r / 56, nb = r % 56, k0 = kb * 64, n0 = nb * 64;
            transpose64(p.w_in + (size_t)k0 * INW + n0 + lane, INW, WinT + k0, D,
                        [=](int slot) { return (n0 < 1024) ? n0 + 2 * (slot & 31) + (slot >> 5) : n0 + slot; }, scr, lane);
            continue;
        }
        r -= I_IN;
        if (r < I_O) {
            const int kb = r >> 4, nb = r & 15, k0 = kb * 64, n0 = nb * 64;
            transpose64(p.w_out + (size_t)k0 * D + n0 + lane, D, WoT + k0, D, [=](int slot) { return n0 + slot; }, scr, lane);
            continue;
        }
        r -= I_O;
        if (r < I_GU) {
            const int e = r >> 8, kb = (r >> 4) & 15, fb = r & 15, k0 = kb * 64, f0 = fb * 32;
            const float* src = ((lane < 32) ? p.w_gate : p.w_up) + (size_t)e * D * DE + (size_t)k0 * DE + f0 + (lane & 31);
            transpose64(src, DE, WguT + (size_t)e * D * D + k0, D,
                        [=](int slot) { const int f = f0 + (slot & 31); return 8 * (f >> 2) + (f & 3) + 4 * (slot >> 5); }, scr, lane);
            continue;
        }
        r -= I_GU;
        {
            const int e = r >> 7, kb = (r >> 4) & 7, nb = r & 15, k0 = kb * 64, n0 = nb * 64;
            transpose64(p.w_down + (size_t)e * DE * D + (size_t)k0 * D + n0 + lane, D, WdT + (size_t)e * D * DE + k0, DE, [=](int slot) { return n0 + slot; }, scr, lane);
        }
    }
}

__device__ __forceinline__ void ph_p1(const Params& p) {
    const float* mod = (const float*)(p.ws + WS_MOD); bf16_t* h1 = (bf16_t*)(p.ws + WS_ACT);
    const int lane = threadIdx.x & 63, wave = threadIdx.x >> 6;
    for (int row = blockIdx.x * 8 + wave; row < M; row += gridDim.x * 8) {
        const int b = row >> 12;
        const float4* xr = (const float4*)(p.x + (size_t)row * D);
        float4 v[4]; float ss = 0.f;
#pragma unroll
        for (int j = 0; j < 4; ++j) { v[j] = xr[lane + 64 * j]; ss += v[j].x * v[j].x + v[j].y * v[j].y + v[j].z * v[j].z + v[j].w * v[j].w; }
        ss = wave_sum(ss);
        const float rstd = 1.0f / sqrtf(ss * (1.0f / D) + EPS);
#pragma unroll
        for (int j = 0; j < 4; ++j) {
            const int c0 = 4 * (lane + 64 * j);
            const float4 g = *(const float4*)(p.g1 + c0);
            const float4 sh = *(const float4*)(mod + b * NMODW + 0 * D + c0);
            const float4 sc = *(const float4*)(mod + b * NMODW + 1 * D + c0);
            const float o0 = v[j].x * rstd * g.x * (1.0f + sc.x) + sh.x, o1 = v[j].y * rstd * g.y * (1.0f + sc.y) + sh.y;
            const float o2 = v[j].z * rstd * g.z * (1.0f + sc.z) + sh.z, o3 = v[j].w * rstd * g.w * (1.0f + sc.w) + sh.w;
            u32x2 w; w.x = pk2(o0, o1); w.y = pk2(o2, o3);
            *(u32x2*)(h1 + (size_t)row * D + c0) = w;
        }
    }
}

__device__ __forceinline__ void ph_p2(const Params& p, LAS unsigned char* lds) {
    StaticSched S; S.init(p.ws + WS_ACT, p.ws + WS_WIN, M, INW, D, (int)gridDim.x, (int)blockIdx.x);
    EpiProj E{(bf16_t*)(p.ws + WS_PROJ), (const float*)(p.ws + WS_ROPE_C), (const float*)(p.ws + WS_ROPE_S)};
    pg8::gemm_phase<EpiProj, StaticSched, true, false>(lds, D, S, E);
}

__device__ __forceinline__ void ph_p4(const Params& p, LAS unsigned char* lds) {
    StaticSched S; S.init(p.ws + WS_ACT, p.ws + WS_WO, M, D, D, (int)gridDim.x, (int)blockIdx.x);
    EpiRes E{p.x, (const float*)(p.ws + WS_MOD), p.out};
    pg8::gemm_phase<EpiRes, StaticSched, true, false>(lds, D, S, E);
}

__device__ __forceinline__ void ph_p5(const Params& p, float* sm) {
    const float* x1 = p.out; bf16_t* h2 = (bf16_t*)(p.ws + WS_ACT);
    const float* mod = (const float*)(p.ws + WS_MOD);
    unsigned* cnt = (unsigned*)(p.ws + WS_CNT); unsigned* tokslot = (unsigned*)(p.ws + WS_TOKSLOT);
    int* list = (int*)(p.ws + WS_LIST); float* listw = (float*)(p.ws + WS_LISTW);
    const int tid = threadIdx.x, lane = tid & 63, wave = tid >> 6;
    constexpr int HLD = 1028;
    float* H = sm;
    float* PART = sm + 16 * HLD;
    float* LOG = PART + 8 * 16 * 36;
    int* DEC_E = (int*)(LOG + 16 * 36);
    float* DEC_W = (float*)(DEC_E + 256);
    int* DEC_R = (int*)(DEC_W + 256);
    int nb = 0;
    const int jn = lane & 15, kk = lane >> 4;
    float bE0[32], bE1[32], bG[32];
#pragma unroll
    for (int s = 0; s < 32; ++s) {
        const size_t k = (size_t)(128 * wave + 4 * s + kk);
        bE0[s] = p.w_expert[k * 32 + jn]; bE1[s] = p.w_expert[k * 32 + 16 + jn]; bG[s] = (jn < 4) ? p.w_group[k * 4 + jn] : 0.f;
    }
    for (int bt = blockIdx.x; bt < M / 16; bt += gridDim.x) {
        const int row0 = bt * 16;
        __syncthreads();
#pragma unroll
        for (int rr = 0; rr < 2; ++rr) {
            const int rl = 2 * wave + rr, row = row0 + rl, b = row >> 12;
            const float4* xr = (const float4*)(x1 + (size_t)row * D);
            float4 v[4]; float ss = 0.f;
#pragma unroll
            for (int j = 0; j < 4; ++j) { v[j] = xr[lane + 64 * j]; ss += v[j].x * v[j].x + v[j].y * v[j].y + v[j].z * v[j].z + v[j].w * v[j].w; }
            ss = wave_sum(ss);
            const float rstd = 1.0f / sqrtf(ss * (1.0f / D) + EPS);
#pragma unroll
            for (int j = 0; j < 4; ++j) {
                const int c0 = 4 * (lane + 64 * j);
                const float4 g = *(const float4*)(p.g2 + c0);
                const float4 sh = *(const float4*)(mod + b * NMODW + 3 * D + c0);
                const float4 sc = *(const float4*)(mod + b * NMODW + 4 * D + c0);
                float4 hv;
                hv.x = v[j].x * rstd * g.x * (1.0f + sc.x) + sh.x; hv.y = v[j].y * rstd * g.y * (1.0f + sc.y) + sh.y;
                hv.z = v[j].z * rstd * g.z * (1.0f + sc.z) + sh.z; hv.w = v[j].w * rstd * g.w * (1.0f + sc.w) + sh.w;
                *(float4*)(H + rl * HLD + c0) = hv;
                u32x2 w; w.x = pk2(hv.x, hv.y); w.y = pk2(hv.z, hv.w);
                *(u32x2*)(h2 + (size_t)row * D + c0) = w;
            }
        }
        __syncthreads();
        f32x4 aE0 = (f32x4){0.f, 0.f, 0.f, 0.f}, aE1 = aE0, aG = aE0;
        const float* Ha = H + jn * HLD + 128 * wave + kk;
#pragma unroll
        for (int s = 0; s < 32; ++s) {
            const float av = Ha[4 * s];
            aE0 = __builtin_amdgcn_mfma_f32_16x16x4f32(av, bE0[s], aE0, 0, 0, 0);
            aE1 = __builtin_amdgcn_mfma_f32_16x16x4f32(av, bE1[s], aE1, 0, 0, 0);
            aG = __builtin_amdgcn_mfma_f32_16x16x4f32(av, bG[s], aG, 0, 0, 0);
        }
#pragma unroll
        for (int r = 0; r < 4; ++r) {
            float* pr = PART + (wave * 16 + 4 * kk + r) * 36;
            pr[4 + jn] = aE0[r]; pr[20 + jn] = aE1[r];
            if (jn < 4) pr[jn] = aG[r];
        }
        __syncthreads();
        for (int idx = tid; idx < 16 * 36; idx += NT) {
            float s = 0.f;
#pragma unroll
            for (int w = 0; w < 8; ++w) s += PART[w * 16 * 36 + idx];
            LOG[idx] = s;
        }
        __syncthreads();
        if (tid < 16) {
            float lg[36];
#pragma unroll
            for (int q = 0; q < 36; ++q) lg[q] = LOG[tid * 36 + q];
            float gl[4]; int gi = 0;
#pragma unroll
            for (int q = 0; q < 4; ++q) gl[q] = lg[q] + p.b_group[q];
            float gmax = gl[0];
#pragma unroll
            for (int q = 1; q < 4; ++q) if (gl[q] > gmax) { gmax = gl[q]; gi = q; }
            float den = 0.f;
#pragma unroll
            for (int q = 0; q < 4; ++q) den += expf(gl[q] - gmax);
            const float gw = 1.0f / den;
            float el[8];
#pragma unroll
            for (int q = 0; q < 8; ++q) {
                float vsel = lg[4 + q];
                if (gi == 1) vsel = lg[4 + 8 + q]; else if (gi == 2) vsel = lg[4 + 16 + q]; else if (gi == 3) vsel = lg[4 + 24 + q];
                el[q] = vsel + p.b_expert[gi * 8 + q];
            }
            int i1 = 0; float v1 = el[0];
#pragma unroll
            for (int q = 1; q < 8; ++q) if (el[q] > v1) { v1 = el[q]; i1 = q; }
            int i2 = -1; float v2 = -INFINITY;
#pragma unroll
            for (int q = 0; q < 8; ++q) if (q != i1 && el[q] > v2) { v2 = el[q]; i2 = q; }
            if (i2 < 0) { i2 = (i1 == 0) ? 1 : 0; v2 = v1; }
            const float e2 = expf(v2 - v1);
            const int n = nb * 32 + tid * 2;
            DEC_E[n] = gi * 8 + i1; DEC_E[n + 1] = gi * 8 + i2; DEC_W[n] = gw / (1.0f + e2); DEC_W[n + 1] = gw * e2 / (1.0f + e2); DEC_R[n >> 1] = row0 + tid;
        }
        ++nb;
    }
    __syncthreads();
    if (tid < NEXP) {
        int c = 0;
        for (int n = 0; n < nb * 32; ++n) c += (DEC_E[n] == tid) ? 1 : 0;
        int pos = c ? (int)atomicAdd(&cnt[tid * 32], (unsigned)c) : 0;
        for (int n = 0; n < nb * 32; ++n) if (DEC_E[n] == tid) {
            const int row = DEC_R[n >> 1];
            list[tid * LISTCAP + pos] = row; listw[tid * LISTCAP + pos] = DEC_W[n];
            tokslot[row * 2 + (n & 1)] = ((unsigned)tid << 16) | (unsigned)pos; ++pos;
        }
    }
}

__device__ __forceinline__ void ph_p6(const Params& p, LAS unsigned char* lds) {
    LAS int* tab = (LAS int*)(lds + TAB_OFF);
    moe_table((const unsigned*)(p.ws + WS_CNT), tab);
    const int G = (int)gridDim.x, bx = (int)blockIdx.x, vc = (G % 8 == 0) ? (bx % 8) * (G / 8) + bx / 8 : bx;
    MoeSched S{tab, (const char*)(p.ws + WS_ACT), (const char*)(p.ws + WS_WGU), (const int*)(p.ws + WS_LIST), D, D * D * 2, 1, G, vc};
    EpiHid E{(bf16_t*)(p.ws + WS_HID), (const int*)(p.ws + WS_LIST), (const float*)(p.ws + WS_LISTW)};
    pg8::gemm_phase<EpiHid, MoeSched, true, true>(lds, D, S, E);
}

__device__ __forceinline__ void ph_p7(const Params& p, LAS unsigned char* lds) {
    LAS int* tab = (LAS int*)(lds + TAB_OFF);
    moe_table((const unsigned*)(p.ws + WS_CNT), tab);
    const int G = (int)gridDim.x, bx = (int)blockIdx.x, vc = (G % 8 == 0) ? (bx % 8) * (G / 8) + bx / 8 : bx;
    MoeSched S{tab, (const char*)(p.ws + WS_HID), (const char*)(p.ws + WS_WD), (const int*)(p.ws + WS_LIST), DE, D * DE * 2, 0, G, vc};
    EpiY E{(bf16_t*)(p.ws + WS_Y)};
    pg8::gemm_phase<EpiY, MoeSched, true, false>(lds, DE, S, E);
}

__device__ __forceinline__ void ph_p8(const Params& p, LAS unsigned char* lds) {
    LAS int* tab = (LAS int*)(lds + TAB_OFF);
    moe_table((const unsigned*)(p.ws + WS_CNT), tab);
    const float* mod = (const float*)(p.ws + WS_MOD); const bf16_t* y = (const bf16_t*)(p.ws + WS_Y); const unsigned* tokslot = (const unsigned*)(p.ws + WS_TOKSLOT);
    const int lane = threadIdx.x & 63, wave = threadIdx.x >> 6;
    for (int row = blockIdx.x * 8 + wave; row < M; row += gridDim.x * 8) {
        const int b = row >> 12;
        const unsigned s0 = tokslot[row * 2], s1 = tokslot[row * 2 + 1];
        const size_t r0 = (size_t)(tab[32 + (s0 >> 16)] + (int)(s0 & 0xffffu)), r1 = (size_t)(tab[32 + (s1 >> 16)] + (int)(s1 & 0xffffu));
        float4 v[4]; float ss = 0.f;
#pragma unroll
        for (int j = 0; j < 4; ++j) {
            const int c0 = 4 * (lane + 64 * j);
            const float4 a = *(const float4*)(p.out + (size_t)row * D + c0), g = *(const float4*)(mod + b * NMODW + 5 * D + c0);
            const u32x2 ya = *(const u32x2*)(y + r0 * D + c0), yb = *(const u32x2*)(y + r1 * D + c0);
            v[j].x = a.x + g.x * (bflo(ya.x) + bflo(yb.x)); v[j].y = a.y + g.y * (bfhi(ya.x) + bfhi(yb.x));
            v[j].z = a.z + g.z * (bflo(ya.y) + bflo(yb.y)); v[j].w = a.w + g.w * (bfhi(ya.y) + bfhi(yb.y));
            ss += v[j].x * v[j].x + v[j].y * v[j].y + v[j].z * v[j].z + v[j].w * v[j].w;
        }
        ss = wave_sum(ss);
        const float rstd = 1.0f / sqrtf(ss * (1.0f / D) + EPS);
#pragma unroll
        for (int j = 0; j < 4; ++j) {
            const int c0 = 4 * (lane + 64 * j);
            const float4 g = *(const float4*)(p.final_gain + c0);
            *(float4*)(p.out + (size_t)row * D + c0) = make_float4(v[j].x * rstd * g.x, v[j].y * rstd * g.y, v[j].z * rstd * g.z, v[j].w * rstd * g.w);
        }
    }
}

namespace ret {
typedef short v4i16_t __attribute__((ext_vector_type(4)));
constexpr int NPART = 8, CP = 32 / NPART;
constexpr int TQ = 16384, BUFB = 3 * TQ;
constexpr int Y_OFF = 2 * BUFB, YLD = 68;
constexpr int LDS_NEED = Y_OFF + 128 * YLD * 4;
__device__ __forceinline__ int crow(int r, int hi) { return (r & 3) + 8 * (r >> 2) + 4 * hi; }
__device__ __forceinline__ unsigned cvtpk(float lo, float hi) { typedef float f32x2_t __attribute__((ext_vector_type(2))); typedef __bf16 bf16x2_t __attribute__((ext_vector_type(2))); f32x2_t v = {lo, hi}; bf16x2_t b = __builtin_convertvector(v, bf16x2_t); return __builtin_bit_cast(unsigned, b); }
#define RT_TR(p) __builtin_amdgcn_ds_read_tr16_b64_v4i16((LAS v4i16_t*)(p))

__device__ __forceinline__ void unit(const bf16_t* proj, bf16_t* mix, const float* gn, int b, int h, int part, LAS unsigned char* lds, const int mode, float* Sbuf, unsigned* flags) {
    const int tid = threadIdx.x, lane = tid & 63, r32 = lane & 31, hi = lane >> 5;
    const int wid = __builtin_amdgcn_readfirstlane(tid >> 6), a = wid & 3, dblk = wid >> 2;
    const size_t tb = (size_t)b * SEQ;
    const float lg2 = log2f(1.0f - exp2f(-5.0f - (float)h));
    const float gC = exp2f((float)RCH * lg2);
    const int cbase = part * CP, bh = b * 8 + h, u = part * 32 + bh;
    const int n_pre = (mode == 0) ? CP : 0, total = CP;
    const bf16_t* qsrc = proj + (tb + lane) * INW + OFF_RQ + h * 64 + wid * 8;
    const bf16_t* ksrc = proj + (tb + lane) * INW + OFF_RK + h * 64 + wid * 8;
    const bf16_t* vsrc = proj + (tb + 16 * wid + (lane >> 2)) * INW + OFF_RV + h * 64 + (lane & 3) * 8;
    const unsigned lds0 = (unsigned)(uintptr_t)lds;
#define RT_GLDS(src, dstoff) glds16((src), (unsigned)__builtin_amdgcn_readfirstlane(lds0 + (dstoff)))
#define RT_ISSUE(ci, bo, withq) do { const size_t _o = (size_t)(cbase + (ci)) * RCH * INW; \
        if (withq) { RT_GLDS(qsrc + _o, (bo) + wid * 2048); RT_GLDS(qsrc + _o + (size_t)64 * INW, (bo) + wid * 2048 + 1024); } \
        RT_GLDS(ksrc + _o, (bo) + TQ + wid * 2048); RT_GLDS(ksrc + _o + (size_t)64 * INW, (bo) + TQ + wid * 2048 + 1024); \
        RT_GLDS(vsrc + _o, (bo) + 2 * TQ + wid * 1024); RT_GLDS(vsrc + _o + 32, (bo) + 2 * TQ + 8192 + wid * 1024); } while (0)
    f32x16 T[2];
#pragma unroll
    for (int kb = 0; kb < 2; ++kb)
#pragma unroll
        for (int r = 0; r < 16; ++r) T[kb][r] = 0.f;
    if (mode == 1 && part > 0) {
        if (wid == 0) {
            const unsigned* fp = flags + (lane < part ? lane : 0) * 32 + bh;
            unsigned spins = 0;
            while (!__all(__hip_atomic_load(fp, __ATOMIC_RELAXED, __HIP_MEMORY_SCOPE_AGENT) != 0u)) { __builtin_amdgcn_s_sleep(2); if (++spins > (1u << 22)) break; }
            __builtin_amdgcn_fence(__ATOMIC_ACQUIRE, "agent");
            asm volatile("s_waitcnt vmcnt(0)" ::: "memory");
        }
        __syncthreads();
        float wgt = 1.0f;
        const float gP = exp2f((float)(RCH * CP) * lg2);
        for (int pp = part - 1; pp >= 0; --pp) {
            const float* Sp = Sbuf + ((size_t)(pp * 32 + bh) * 2 + dblk) * 2 * 16 * 64 + lane;
#pragma unroll
            for (int kb = 0; kb < 2; ++kb)
#pragma unroll
                for (int r = 0; r < 16; ++r) T[kb][r] += wgt * Sp[(kb * 16 + r) * 64];
            wgt *= gP;
        }
    }
    const int vofs = 2 * TQ + dblk * 8192 + ((lane >> 4) & 1) * 32 + (lane & 3) * 8 + (4 * hi + ((lane & 15) >> 2)) * 64;
    const int g16 = (lane >> 4) & 1, q4 = (lane & 15) >> 2, p4 = lane & 3;
    const int ktofs = TQ + (2 * g16 + (p4 >> 1)) * 2048 + (4 * hi + q4) * 16 + (p4 & 1) * 8;
    const int rowofs = (32 * a + r32) * 16;
    RT_ISSUE(0, 0, (mode == 1));
    for (int ci = 0; ci < total; ++ci) {
        const int bo = (ci & 1) * BUFB;
        const bool outp = (mode == 1);
        asm volatile("s_waitcnt vmcnt(0)" ::: "memory");
        __builtin_amdgcn_s_barrier();
        asm volatile("" ::: "memory");
        if (ci + 1 < total) RT_ISSUE(ci + 1, BUFB - bo, (mode == 1));
        if (outp) {
            f32x16 o;
#pragma unroll
            for (int r = 0; r < 16; ++r) o[r] = 0.f;
#pragma unroll
            for (int kb = 0; kb < 2; ++kb)
#pragma unroll
                for (int s = 0; s < 2; ++s) {
                    const u32x2 qa = *(const LAS u32x2*)(lds + bo + (4 * kb + 2 * s) * 2048 + rowofs + 8 * hi);
                    const u32x2 qb = *(const LAS u32x2*)(lds + bo + (4 * kb + 2 * s + 1) * 2048 + rowofs + 8 * hi);
                    const u32x4 af = (u32x4){qa.x, qa.y, qb.x, qb.y};
                    const u32x4 bf = (u32x4){cvtpk(T[kb][8 * s + 0], T[kb][8 * s + 1]), cvtpk(T[kb][8 * s + 2], T[kb][8 * s + 3]), cvtpk(T[kb][8 * s + 4], T[kb][8 * s + 5]), cvtpk(T[kb][8 * s + 6], T[kb][8 * s + 7])};
                    o = __builtin_amdgcn_mfma_f32_32x32x16_bf16(__builtin_bit_cast(bf16x8, af), __builtin_bit_cast(bf16x8, bf), o, 0, 0, 0);
                }
#pragma unroll
            for (int r = 0; r < 16; ++r) o[r] *= gC;
            bf16x8 qr[4];
#pragma unroll
            for (int d0 = 0; d0 < 4; ++d0) qr[d0] = *(const LAS bf16x8*)(lds + bo + (2 * d0 + hi) * 2048 + rowofs);
            for (int jb = 0; jb <= a; ++jb) {
                f32x16 s;
#pragma unroll
                for (int r = 0; r < 16; ++r) s[r] = 0.f;
#pragma unroll
                for (int d0 = 0; d0 < 4; ++d0) {
                    const bf16x8 kf = *(const LAS bf16x8*)(lds + bo + TQ + (2 * d0 + hi) * 2048 + (32 * jb + r32) * 16);
                    s = __builtin_amdgcn_mfma_f32_32x32x16_bf16(kf, qr[d0], s, 0, 0, 0);
                }
                if (jb == a) {
#pragma unroll
                    for (int r = 0; r < 16; ++r) if (crow(r, hi) > r32) s[r] = 0.f;
                }
                const u32x4 pa0 = (u32x4){cvtpk(s[0], s[1]), cvtpk(s[2], s[3]), cvtpk(s[4], s[5]), cvtpk(s[6], s[7])};
                const u32x4 pa1 = (u32x4){cvtpk(s[8], s[9]), cvtpk(s[10], s[11]), cvtpk(s[12], s[13]), cvtpk(s[14], s[15])};
                {
                    const v4i16_t lo = RT_TR(lds + bo + vofs + (2 * jb) * 1024), hv = RT_TR(lds + bo + vofs + (2 * jb) * 1024 + 512);
                    const bf16x8 vf = (bf16x8){lo[0], lo[1], lo[2], lo[3], hv[0], hv[1], hv[2], hv[3]};
                    o = __builtin_amdgcn_mfma_f32_32x32x16_bf16(__builtin_bit_cast(bf16x8, pa0), vf, o, 0, 0, 0);
                }
                {
                    const v4i16_t lo = RT_TR(lds + bo + vofs + (2 * jb + 1) * 1024), hv = RT_TR(lds + bo + vofs + (2 * jb + 1) * 1024 + 512);
                    const bf16x8 vf = (bf16x8){lo[0], lo[1], lo[2], lo[3], hv[0], hv[1], hv[2], hv[3]};
                    o = __builtin_amdgcn_mfma_f32_32x32x16_bf16(__builtin_bit_cast(bf16x8, pa1), vf, o, 0, 0, 0);
                }
            }
            LAS float* Y = (LAS float*)(lds + Y_OFF);
#pragma unroll
            for (int r = 0; r < 16; ++r) Y[(32 * a + crow(r, hi)) * YLD + 32 * dblk + r32] = o[r];
        }
        if (mode == 0 || ci + 1 < total) {
#pragma unroll
            for (int kb = 0; kb < 2; ++kb)
#pragma unroll
                for (int r = 0; r < 16; ++r) T[kb][r] *= gC;
            const int ts_lo = outp ? 0 : 2 * a, ts_hi = outp ? 8 : 2 * a + 2;
#pragma unroll 2
            for (int ts = ts_lo; ts < ts_hi; ++ts) {
                const v4i16_t vlo = RT_TR(lds + bo + vofs + ts * 1024), vhv = RT_TR(lds + bo + vofs + ts * 1024 + 512);
                const bf16x8 vf = (bf16x8){vlo[0], vlo[1], vlo[2], vlo[3], vhv[0], vhv[1], vhv[2], vhv[3]};
#pragma unroll
                for (int kb = 0; kb < 2; ++kb) {
                    const v4i16_t klo = RT_TR(lds + bo + ktofs + kb * 8192 + ts * 256), khv = RT_TR(lds + bo + ktofs + kb * 8192 + ts * 256 + 128);
                    const bf16x8 kf = (bf16x8){klo[0], klo[1], klo[2], klo[3], khv[0], khv[1], khv[2], khv[3]};
                    T[kb] = __builtin_amdgcn_mfma_f32_32x32x16_bf16(kf, vf, T[kb], 0, 0, 0);
                }
            }
            if (mode == 0 && ci + 1 == total) {
                LAS float* R = (LAS float*)(lds + Y_OFF);
#pragma unroll
                for (int kb = 0; kb < 2; ++kb) {
#pragma unroll
                    for (int r = 0; r < 16; ++r) R[(wid * 16 + r) * 64 + lane] = T[kb][r];
                    asm volatile("s_waitcnt lgkmcnt(0)" ::: "memory");
                    __builtin_amdgcn_s_barrier();
                    asm volatile("" ::: "memory");
#pragma unroll
                    for (int r = 0; r < 16; ++r) {
                        const LAS float* rp = R + ((dblk * 4) * 16 + r) * 64 + lane;
                        T[kb][r] = (rp[0] + rp[16 * 64]) + (rp[2 * 16 * 64] + rp[3 * 16 * 64]);
                    }
                    asm volatile("s_waitcnt lgkmcnt(0)" ::: "memory");
                    __builtin_amdgcn_s_barrier();
                    asm volatile("" ::: "memory");
                }
            }
        }
        if (outp) {
            asm volatile("s_waitcnt lgkmcnt(0)" ::: "memory");
            __builtin_amdgcn_s_barrier();
            asm volatile("" ::: "memory");
            const int row = tid >> 2, qd = tid & 3;
            const LAS float* yr = (const LAS float*)(lds + Y_OFF) + row * YLD + 16 * qd;
            float v[16];
#pragma unroll
            for (int i = 0; i < 4; ++i) { const f32x4 t4 = *(const LAS f32x4*)(yr + 4 * i); v[4 * i] = t4[0]; v[4 * i + 1] = t4[1]; v[4 * i + 2] = t4[2]; v[4 * i + 3] = t4[3]; }
            float s1 = 0.f;
#pragma unroll
            for (int i = 0; i < 16; ++i) s1 += v[i];
            s1 += __shfl_xor(s1, 1); s1 += __shfl_xor(s1, 2);
            const float mu = s1 * (1.0f / 64.0f);
            float s2 = 0.f;
#pragma unroll
            for (int i = 0; i < 16; ++i) { v[i] -= mu; s2 += v[i] * v[i]; }
            s2 += __shfl_xor(s2, 1); s2 += __shfl_xor(s2, 2);
            const float rstd = 1.0f / sqrtf(s2 * (1.0f / 64.0f) + EPS);
            const size_t t = tb + (size_t)(cbase + ci) * RCH + row;
            const u32x4 g0 = *(const u32x4*)(proj + t * INW + OFF_RG + h * 64 + 16 * qd), g1 = *(const u32x4*)(proj + t * INW + OFF_RG + h * 64 + 16 * qd + 8);
            const unsigned gw[8] = {g0.x, g0.y, g0.z, g0.w, g1.x, g1.y, g1.z, g1.w};
            unsigned ow[8];
#pragma unroll
            for (int i = 0; i < 8; ++i) {
                const float ga = bflo(gw[i]), gb = bfhi(gw[i]);
                const float oa = v[2 * i] * rstd * gn[h * 64 + 16 * qd + 2 * i] * siluf(ga), ob = v[2 * i + 1] * rstd * gn[h * 64 + 16 * qd + 2 * i + 1] * siluf(gb);
                ow[i] = cvtpk(oa, ob);
            }
            *(u32x4*)(mix + t * D + h * 64 + 16 * qd) = (u32x4){ow[0], ow[1], ow[2], ow[3]};
            *(u32x4*)(mix + t * D + h * 64 + 16 * qd + 8) = (u32x4){ow[4], ow[5], ow[6], ow[7]};
        }
    }
    if (mode == 0) {
        if (a == 0) {
            float* Sp = Sbuf + ((size_t)u * 2 + dblk) * 2 * 16 * 64 + lane;
#pragma unroll
            for (int kb = 0; kb < 2; ++kb)
#pragma unroll
                for (int r = 0; r < 16; ++r) Sp[(kb * 16 + r) * 64] = T[kb][r];
        }
        asm volatile("s_waitcnt vmcnt(0)" ::: "memory");
        __syncthreads();
        if (tid == 0) {
            __builtin_amdgcn_fence(__ATOMIC_RELEASE, "agent");
            asm volatile("s_waitcnt vmcnt(0)" ::: "memory");
            __hip_atomic_store(flags + u, 1u, __ATOMIC_RELAXED, __HIP_MEMORY_SCOPE_AGENT);
        }
    }
    asm volatile("s_waitcnt lgkmcnt(0)" ::: "memory");
    __builtin_amdgcn_s_barrier();
    asm volatile("" ::: "memory");
#undef RT_GLDS
#undef RT_ISSUE
}
#undef RT_TR
}

__device__ __forceinline__ void ph_ret(const Params& p, LAS unsigned char* lds, const int mode) {
    const bf16_t* proj = (const bf16_t*)(p.ws + WS_PROJ); bf16_t* mix = (bf16_t*)(p.ws + WS_ACT);
    float* Sbuf = (float*)(p.ws + WS_RSTATE); unsigned* flags = (unsigned*)(p.ws + WS_RFLAG);
    for (int u = blockIdx.x; u < 32 * ret::NPART; u += gridDim.x) {
        const int bh = u & 31, part = u >> 5;
        if (mode == 0 && part == ret::NPART - 1) continue;
        ret::unit(proj, mix, p.ret_gn, bh >> 3, bh & 7, part, lds, mode, Sbuf, flags);
    }
}

namespace dattn {
typedef short v4i16_t __attribute__((ext_vector_type(4)));
constexpr int KB_BYTES = 8192, VB_BYTES = 16384;
constexpr int K_OFF = 0, V_OFF = 6 * KB_BYTES;
constexpr int WSF_OFF = V_OFF + 4 * VB_BYTES;
constexpr int LDS_NEED = WSF_OFF + 8 * 64 * 4;
constexpr float THR = 8.0f;
__device__ __forceinline__ int crow(int r, int hi) { return (r & 3) + 8 * (r >> 2) + 4 * hi; }
__device__ __forceinline__ unsigned cvtpk(float lo, float hi) { typedef float f32x2_t __attribute__((ext_vector_type(2))); typedef __bf16 bf16x2_t __attribute__((ext_vector_type(2))); f32x2_t v = {lo, hi}; bf16x2_t b = __builtin_convertvector(v, bf16x2_t); return __builtin_bit_cast(unsigned, b); }

__device__ __forceinline__ void unit(const bf16_t* proj, bf16_t* mix, const float* subln, float lam, int b, int h, int qb, LAS unsigned char* lds) {
    const int tid = threadIdx.x, lane = tid & 63, r32 = lane & 31, hi = lane >> 5;
    const int wid = __builtin_amdgcn_readfirstlane(tid >> 6), mp = wid >> 2, rblk = wid & 3;
    const size_t tb = (size_t)b * SEQ; const int q0 = qb * 128;
    const int NTL = 2 * (qb + 1);
    const bf16_t* Kg = proj + tb * INW + OFF_DK + h * 128;
    const bf16_t* Vg = proj + tb * INW + OFF_DV + h * 128;
    const bf16_t* ksrc0 = Kg + (size_t)lane * INW + wid * 8;
    const bf16_t* ksrc1 = ksrc0 + 64;
    const bf16_t* vsrcA = Vg + (size_t)(16 * (wid & 3) + (lane >> 2)) * INW + (wid >> 2) * 32 + (lane & 3) * 8;
    const bf16_t* vsrcB = vsrcA + 64;
    LAS float* wsf = (LAS float*)(lds + WSF_OFF) + wid * 64;
    const unsigned lds0 = (unsigned)(uintptr_t)lds;
#define DA_ISSUE(t, ko, vo) do { const size_t _o = (size_t)(t) * 64 * INW; \
        glds16(ksrc0 + _o, (unsigned)__builtin_amdgcn_readfirstlane(lds0 + (ko) + wid * 1024)); \
        glds16(ksrc1 + _o, (unsigned)__builtin_amdgcn_readfirstlane(lds0 + (ko) + KB_BYTES + wid * 1024)); \
        glds16(vsrcA + _o, (unsigned)__builtin_amdgcn_readfirstlane(lds0 + (vo) + wid * 1024)); \
        glds16(vsrcB + _o, (unsigned)__builtin_amdgcn_readfirstlane(lds0 + (vo) + 8192 + wid * 1024)); } while (0)
    DA_ISSUE(0, K_OFF, V_OFF);
    DA_ISSUE(1, K_OFF + 2 * KB_BYTES, V_OFF + VB_BYTES);
    const bf16_t* Qw = proj + (tb + q0 + rblk * 32 + r32) * INW + OFF_DQ + h * 128 + mp * 64 + hi * 8;
    bf16x8 qr[4];
#pragma unroll
    for (int d0 = 0; d0 < 4; ++d0) qr[d0] = *(const bf16x8*)(Qw + d0 * 16);
    asm volatile("" : "+v"(qr[0]), "+v"(qr[1]), "+v"(qr[2]), "+v"(qr[3]));
    f32x16 o[4];
#pragma unroll
    for (int d0 = 0; d0 < 4; ++d0)
#pragma unroll
        for (int r = 0; r < 16; ++r) o[d0][r] = 0.f;
    float mhat = 0.f, lrun = 0.f;
    f32x16 negm;
#pragma unroll
    for (int r = 0; r < 16; ++r) negm[r] = 0.f;
    const int qrow = q0 + rblk * 32 + r32;
    const int kofs = K_OFF + mp * KB_BYTES + hi * 1024 + r32 * 16;
    const int vofs = V_OFF + ((lane >> 4) & 1) * 32 + (lane & 3) * 8 + (4 * hi + ((lane & 15) >> 2)) * 64;
    u32x4 pw[4];
#pragma unroll
    for (int i = 0; i < 4; ++i) pw[i] = (u32x4){0u, 0u, 0u, 0u};
    int vs_prev = 0, vs_cur = 0, vs_next = VB_BYTES, vs_n2 = 2 * VB_BYTES;
    int ks_cur = 0, ks_n2 = 4 * KB_BYTES;
#define DA_VLD(dst, vslot, d0) do { _Pragma("unroll") for (int ks = 0; ks < 4; ++ks) { \
        dst[2 * ks] = __builtin_amdgcn_ds_read_tr16_b64_v4i16((LAS v4i16_t*)(lds + (vslot) + vofs + (d0) * 4096 + ks * 1024)); \
        dst[2 * ks + 1] = __builtin_amdgcn_ds_read_tr16_b64_v4i16((LAS v4i16_t*)(lds + (vslot) + vofs + (d0) * 4096 + ks * 1024 + 512)); } } while (0)
#define DA_VMM(src, d0) do { _Pragma("unroll") for (int ks = 0; ks < 4; ++ks) { \
        const bf16x8 vf_ = (bf16x8){src[2 * ks][0], src[2 * ks][1], src[2 * ks][2], src[2 * ks][3], src[2 * ks + 1][0], src[2 * ks + 1][1], src[2 * ks + 1][2], src[2 * ks + 1][3]}; \
        o[d0] = __builtin_amdgcn_mfma_f32_32x32x16_bf16(__builtin_bit_cast(bf16x8, pw[ks]), vf_, o[d0], 0, 0, 0); } } while (0)
#define DA_PV(vslot) do { v4i16_t va_[8], vb_[8]; \
        DA_VLD(va_, vslot, 0); __builtin_amdgcn_sched_barrier(0); \
        DA_VLD(vb_, vslot, 1); __builtin_amdgcn_sched_barrier(0); DA_VMM(va_, 0); __builtin_amdgcn_sched_barrier(0); \
        DA_VLD(va_, vslot, 2); __builtin_amdgcn_sched_barrier(0); DA_VMM(vb_, 1); __builtin_amdgcn_sched_barrier(0); \
        DA_VLD(vb_, vslot, 3); __builtin_amdgcn_sched_barrier(0); DA_VMM(va_, 2); __builtin_amdgcn_sched_barrier(0); \
        DA_VMM(vb_, 3); } while (0)
    for (int t = 0; t < NTL; ++t) {
        const int ko = ks_cur;
        if (t + 1 < NTL) asm volatile("s_waitcnt vmcnt(4)" ::: "memory"); else asm volatile("s_waitcnt vmcnt(0)" ::: "memory");
        __builtin_amdgcn_s_barrier();
        asm volatile("" ::: "memory");
        if (t + 2 < NTL) DA_ISSUE(t + 2, K_OFF + ks_n2, V_OFF + vs_n2);
        if (mp == 1 && t > 0) DA_PV(vs_prev);
        f32x16 p0, p1;
#pragma unroll
        for (int d0 = 0; d0 < 4; ++d0) {
            const bf16x8 k0 = *(const LAS bf16x8*)(lds + ko + kofs + d0 * 2048);
            const bf16x8 k1 = *(const LAS bf16x8*)(lds + ko + kofs + d0 * 2048 + 512);
            p0 = __builtin_amdgcn_mfma_f32_32x32x16_bf16(k0, qr[d0], d0 == 0 ? negm : p0, 0, 0, 0);
            p1 = __builtin_amdgcn_mfma_f32_32x32x16_bf16(k1, qr[d0], d0 == 0 ? negm : p1, 0, 0, 0);
        }
        const int j0 = t * 64;
        if (t >= NTL - 2) {
#pragma unroll
            for (int r = 0; r < 16; ++r) { const int kv = j0 + crow(r, hi); if (kv > qrow) p0[r] = -INFINITY; if (kv + 32 > qrow) p1[r] = -INFINITY; }
        }
        float rm = fmaxf(p0[0], p1[0]);
#pragma unroll
        for (int r = 1; r < 16; ++r) rm = fmaxf(rm, fmaxf(p0[r], p1[r]));
        rm = fmaxf(rm, __shfl_xor(rm, 32));
        if (t == 0 || __any(rm > THR)) {
            const float dl = (t == 0) ? rm : fmaxf(rm, 0.f);
            mhat += dl;
#pragma unroll
            for (int r = 0; r < 16; ++r) { p0[r] -= dl; p1[r] -= dl; negm[r] = -mhat; }
            const float alpha = __builtin_amdgcn_exp2f(-dl);
            lrun *= alpha;
            if (hi == 0) wsf[r32] = alpha;
            asm volatile("s_waitcnt lgkmcnt(0)" ::: "memory");
            float al[16];
#pragma unroll
            for (int r = 0; r < 16; ++r) al[r] = wsf[crow(r, hi)];
#pragma unroll
            for (int d0 = 0; d0 < 4; ++d0)
#pragma unroll
                for (int r = 0; r < 16; ++r) o[d0][r] *= al[r];
        }
        float ps = 0.f;
#pragma unroll
        for (int r = 0; r < 16; ++r) { p0[r] = __builtin_amdgcn_exp2f(p0[r]); p1[r] = __builtin_amdgcn_exp2f(p1[r]); ps += p0[r] + p1[r]; }
        lrun += ps;
        pw[0] = (u32x4){cvtpk(p0[0], p0[1]), cvtpk(p0[2], p0[3]), cvtpk(p0[4], p0[5]), cvtpk(p0[6], p0[7])};
        pw[1] = (u32x4){cvtpk(p0[8], p0[9]), cvtpk(p0[10], p0[11]), cvtpk(p0[12], p0[13]), cvtpk(p0[14], p0[15])};
        pw[2] = (u32x4){cvtpk(p1[0], p1[1]), cvtpk(p1[2], p1[3]), cvtpk(p1[4], p1[5]), cvtpk(p1[6], p1[7])};
        pw[3] = (u32x4){cvtpk(p1[8], p1[9]), cvtpk(p1[10], p1[11]), cvtpk(p1[12], p1[13]), cvtpk(p1[14], p1[15])};
        if (mp == 0) DA_PV(vs_cur);
        vs_prev = vs_cur; vs_cur = vs_next; vs_next = vs_n2; vs_n2 = (vs_n2 == 3 * VB_BYTES) ? 0 : vs_n2 + VB_BYTES;
        ks_cur = (ks_cur == 4 * KB_BYTES) ? 0 : ks_cur + 2 * KB_BYTES; ks_n2 = (ks_n2 == 4 * KB_BYTES) ? 0 : ks_n2 + 2 * KB_BYTES;
    }
    if (mp == 1) DA_PV(vs_prev);
    lrun += __shfl_xor(lrun, 32);
    if (hi == 0) wsf[32 + r32] = 1.0f / lrun;
    asm volatile("s_waitcnt lgkmcnt(0)" ::: "memory");
    float rl[16];
#pragma unroll
    for (int r = 0; r < 16; ++r) rl[r] = wsf[32 + crow(r, hi)];
#pragma unroll
    for (int d0 = 0; d0 < 4; ++d0)
#pragma unroll
        for (int r = 0; r < 16; ++r) o[d0][r] *= rl[r];
    asm volatile("s_waitcnt lgkmcnt(0)" ::: "memory");
    __builtin_amdgcn_s_barrier();
    asm volatile("" ::: "memory");
    LAS float* X = (LAS float*)lds + rblk * 4096;
    if (mp == 1) {
#pragma unroll
        for (int d0 = 0; d0 < 4; ++d0)
#pragma unroll
            for (int r = 0; r < 16; ++r) X[(d0 * 16 + r) * 64 + lane] = o[d0][r];
    }
    asm volatile("s_waitcnt lgkmcnt(0)" ::: "memory");
    __builtin_amdgcn_s_barrier();
    asm volatile("" ::: "memory");
    if (mp == 0) {
        float ss[16];
#pragma unroll
        for (int r = 0; r < 16; ++r) ss[r] = 0.f;
#pragma unroll
        for (int d0 = 0; d0 < 4; ++d0)
#pragma unroll
            for (int r = 0; r < 16; ++r) { const float dv = o[d0][r] - lam * X[(d0 * 16 + r) * 64 + lane]; o[d0][r] = dv; ss[r] += dv * dv; }
#pragma unroll
        for (int r = 0; r < 16; ++r) {
            float s = ss[r];
            s += __shfl_xor(s, 1); s += __shfl_xor(s, 2); s += __shfl_xor(s, 4); s += __shfl_xor(s, 8); s += __shfl_xor(s, 16);
            ss[r] = (1.0f - LAMBDA_INIT) / sqrtf(s * (1.0f / 128.0f) + EPS);
        }
        bf16_t* mrow = mix + (tb + q0 + rblk * 32) * D + 512 + h * 128 + r32;
#pragma unroll
        for (int d0 = 0; d0 < 4; ++d0) {
            const float g = subln[d0 * 32 + r32];
#pragma unroll
            for (int r = 0; r < 16; ++r) mrow[(size_t)crow(r, hi) * D + d0 * 32] = (bf16_t)f2bf(o[d0][r] * ss[r] * g);
        }
    }
    asm volatile("s_waitcnt lgkmcnt(0)" ::: "memory");
    __builtin_amdgcn_s_barrier();
    asm volatile("" ::: "memory");
#undef DA_ISSUE
#undef DA_PV
#undef DA_VLD
#undef DA_VMM
}
}

__device__ __forceinline__ void ph_attn(const Params& p, LAS unsigned char* lds) {
    float lam;
    { float a = 0.f, bq = 0.f; for (int i = 0; i < 64; ++i) { a += p.lq1[i] * p.lk1[i]; bq += p.lq2[i] * p.lk2[i]; } lam = expf(a) - expf(bq) + LAMBDA_INIT; }
    const bf16_t* proj = (const bf16_t*)(p.ws + WS_PROJ); bf16_t* mix = (bf16_t*)(p.ws + WS_ACT);
    for (int k = 2 * (int)blockIdx.x; k < 512; k += 2 * (int)gridDim.x)
        for (int half = 0; half < 2; ++half) {
            const int uu = half ? 511 - (k >> 1) : (k >> 1);
            const int qb = 31 - uu / 16, bh = uu % 16;
            dattn::unit(proj, mix, p.subln, lam, bh >> 2, bh & 3, qb, lds);
        }
}
constexpr int NPHASE = 9;

__global__ void __launch_bounds__(NT, 2) mega(Params p) {
    extern __shared__ __attribute__((aligned(16))) unsigned char lds_raw[];
    float* sm = (float*)lds_raw;
    LAS unsigned char* lds = (LAS unsigned char*)lds_raw;
    volatile LAS unsigned* MISC = (volatile LAS unsigned*)(lds + MISC_OFF);
    if (threadIdx.x < 32) MISC[threadIdx.x] = 0u;
    __syncthreads();
    const XcdBarrier bar = xcd_barrier_post((unsigned*)(p.ws + WS_BAR), MISC + 8);
#define PH(k) (p.ph_lo <= (k) && (k) < p.ph_hi)
#define SYNC(k) do { if (PH(k) && PH((k) + 1)) xcd_barrier(bar); } while (0)
    if (PH(0)) ph_p0(p, sm, lds);
    SYNC(0);
    if (PH(1)) ph_p1(p);
    SYNC(1);
    if (PH(2)) ph_p2(p, lds);
    SYNC(2);
    if (PH(3)) { ph_ret(p, lds, 0); ph_attn(p, lds); ph_ret(p, lds, 1); }
    SYNC(3);
    if (PH(4)) ph_p4(p, lds);
    SYNC(4);
    if (PH(5)) ph_p5(p, sm);
    SYNC(5);
    if (PH(6)) ph_p6(p, lds);
    SYNC(6);
    if (PH(7)) ph_p7(p, lds);
    SYNC(7);
    if (PH(8)) ph_p8(p, lds);
#undef PH
#undef SYNC
}

#ifndef N_LAUNCHES
#define N_LAUNCHES 1
#endif

extern "C" void kernel_launch(void* const* d_in, const int* in_sizes, int n_in, void* d_out, int out_size, void* d_ws, size_t ws_size, hipStream_t stream) {
    static int grid = 0;
    if (grid == 0) {
        if (n_in != 22 || in_sizes[0] != M * D || out_size != M * D || ws_size < WS_END) {
            fprintf(stderr, "kernel_launch: unexpected shapes (n_in %d, in0 %d, out %d, ws %zu)\n", n_in, n_in > 0 ? in_sizes[0] : -1, out_size, ws_size); grid = -1; return; }
        int dev = 0, cus = 0, per_cu = 0;
        (void)hipGetDevice(&dev);
        (void)hipDeviceGetAttribute(&cus, hipDeviceAttributeMultiprocessorCount, dev);
        (void)hipFuncSetAttribute((const void*)mega, hipFuncAttributeMaxDynamicSharedMemorySize, LDS_BYTES);
        (void)hipOccupancyMaxActiveBlocksPerMultiprocessor(&per_cu, (const void*)mega, NT, LDS_BYTES);
        if (per_cu < 1) { fprintf(stderr, "kernel_launch: occupancy query says %d\n", per_cu); grid = -1; return; }
        grid = cus;
    }
    if (grid < 0) return;
    (void)hipMemsetAsync((char*)d_ws + WS_BAR, 0, 32768, stream);
    Params p{};
    const float** f = (const float**)&p;
    for (int i = 0; i < 22; ++i) f[i] = (const float*)d_in[i];
    p.out = (float*)d_out; p.ws = (unsigned char*)d_ws;
    if (N_LAUNCHES == 1) {
        p.ph_lo = 0; p.ph_hi = NPHASE;
        hipLaunchKernelGGL(mega, dim3(grid), dim3(NT), LDS_BYTES, stream, p);
    } else {
        for (int k = 0; k < NPHASE; ++k) { p.ph_lo = k; p.ph_hi = k + 1; hipLaunchKernelGGL(mega, dim3(grid), dim3(NT), LDS_BYTES, stream, p); }
    }
}
```
